# Optimizing an MI355X kernel written in HIP

```python
import math
import jax, jax.numpy as jnp
from jax import lax
import numpy as np

D_MODEL = 1024
BATCH = 4
SEQ = 4096
DEPTH = 1

D_MIX = D_MODEL
W_A = D_MIX // 2
W_B = D_MIX - W_A
CHUNK = 128
HEADS_A = 8
DH_A = W_A // HEADS_A
SPATIAL_INIT_STD = 0.02
S5_GROUP = 16
S5_GROUPS = W_B // S5_GROUP
S5_STATE = 64
DT_MIN = 1e-3
DT_MAX = 1e-1
N_EXPERT_GROUPS = 4
EXPERTS_PER_GROUP = 8
TOP_K = 2
D_EXPERT = 256
PLE_DIM = 256
EPS = 1e-6

kernel_name = "hymba_gmlp_s5_hmoe_block"


def rmsnorm(x, g):
    xf = x.astype(jnp.float32)
    y = xf * lax.rsqrt(jnp.mean(xf * xf, axis=-1, keepdims=True) + EPS)
    return (y * g.astype(jnp.float32)).astype(x.dtype)


def gmlp_mixer(u, v, sgu_gain, w_s, b_s):
    bsz, seq, _ = u.shape
    u = jax.nn.gelu(u)
    v = rmsnorm(jax.nn.gelu(v), sgu_gain)
    v = v.reshape(bsz, seq // CHUNK, CHUNK, HEADS_A, DH_A)
    mask = jnp.tril(jnp.ones((CHUNK, CHUNK), dtype=v.dtype))
    z = jnp.einsum('hts,bcshd->bcthd', w_s * mask, v) + b_s.T[None, None, :, :, None]
    return u * z.reshape(bsz, seq, W_A)


def s5_mixer(s, a_re, a_im, log_dt, b_re, b_im, c_re, c_im, d_skip, w_glu, b_glu):
    dtype = s.dtype
    f32 = jnp.float32
    bsz, seq, _ = s.shape
    sf = s.astype(f32)
    lam = lax.complex(a_re.astype(f32), a_im.astype(f32))
    dt = jnp.exp(log_dt.astype(f32))[:, None]
    a_bar = jnp.exp(lam * dt)
    b_mat = lax.complex(b_re.astype(f32), b_im.astype(f32))
    b_bar = ((a_bar - 1.0) / lam)[..., None] * b_mat
    ug = sf.reshape(bsz, seq, S5_GROUPS, S5_GROUP).astype(jnp.complex64)
    bu = jnp.einsum('gpc,bsgc->bsgp', b_bar, ug)
    a_seq = jnp.broadcast_to(a_bar, bu.shape)

    def combine(left, right):
        a_l, b_l = left
        a_r, b_r = right
        return a_r * a_l, a_r * b_l + b_r

    _, states = lax.associative_scan(combine, (a_seq, bu), axis=1)
    c_mat = lax.complex(c_re.astype(f32), c_im.astype(f32))
    y = jnp.einsum('gcp,bsgp->bsgc', c_mat, states).real.reshape(bsz, seq, W_B)
    y = jax.nn.gelu(y + d_skip.astype(f32) * sf)
    gl = y @ w_glu.astype(f32) + b_glu.astype(f32)
    out = gl[..., :W_B] * jax.nn.sigmoid(gl[..., W_B:])
    return out.astype(dtype)


def hier_moe(xn, w_coarse, b_coarse, w_fine, b_fine, w_gate_e, w_up_e, w_down_e):
    bsz, seq, d = xn.shape
    n = bsz * seq
    xt = xn.reshape(n, d)
    xf = xt.astype(jnp.float32)
    pc = jax.nn.softmax(xf @ w_coarse.astype(jnp.float32) + b_coarse.astype(jnp.float32), axis=-1)
    g_sel = jnp.argmax(pc, axis=-1)
    p_g = jnp.max(pc, axis=-1)
    lf_all = jnp.einsum('nd,gde->nge', xf, w_fine.astype(jnp.float32)) + b_fine.astype(jnp.float32)
    lf = jnp.take_along_axis(lf_all, g_sel[:, None, None], axis=1)[:, 0]
    pf = jax.nn.softmax(lf, axis=-1)
    top_v, top_i = lax.top_k(pf, TOP_K)
    top_w = top_v / jnp.sum(top_v, axis=-1, keepdims=True) * p_g[:, None]
    comb_e = jnp.sum(jax.nn.one_hot(top_i, EXPERTS_PER_GROUP, dtype=jnp.float32) * top_w[..., None], axis=1)
    comb = (jax.nn.one_hot(g_sel, N_EXPERT_GROUPS, dtype=jnp.float32)[:, :, None] * comb_e[:, None, :]).astype(xt.dtype)
    y = jnp.zeros((n, d), dtype=xt.dtype)
    for g in range(N_EXPERT_GROUPS):
        h = jax.nn.silu(jnp.einsum('nd,edf->nef', xt, w_gate_e[g])) * jnp.einsum('nd,edf->nef', xt, w_up_e[g])
        y = y + jnp.einsum('nef,efd->nd', h * comb[:, g, :, None], w_down_e[g])
    return y.reshape(bsz, seq, d)


def setup_inputs(seed: int = 0) -> dict:
    key = jax.random.key(seed)
    ks = iter(jax.random.split(key, 40))
    L, D = DEPTH, D_MODEL
    G, P, C = S5_GROUPS, S5_STATE, S5_GROUP
    NG, EPG, F = N_EXPERT_GROUPS, EXPERTS_PER_GROUP, D_EXPERT
    nrm = lambda shape, std: jax.random.normal(next(ks), shape, jnp.float32) * std
    gain = lambda shape: 1.0 + nrm(shape, 0.02)
    n_idx = jnp.arange(P, dtype=jnp.float32)
    return {
        "x": nrm((BATCH, SEQ, D), 1.0),
        "p": nrm((L, BATCH, SEQ, PLE_DIM), 1.0),
        "norm1": gain((L, D)),
        "w_in": nrm((L, D, 2 * W_A + W_B), D ** -0.5),
        "sgu_norm": gain((L, W_A)),
        "w_spatial": nrm((L, HEADS_A, CHUNK, CHUNK), SPATIAL_INIT_STD),
        "b_spatial": gain((L, HEADS_A, CHUNK)),
        "a_re": -0.5 + nrm((L, G, P), 0.01),
        "a_im": math.pi * n_idx[None, None, :] + nrm((L, G, P), 0.01),
        "log_dt": jax.random.uniform(next(ks), (L, G), jnp.float32, math.log(DT_MIN), math.log(DT_MAX)),
        "b_re": nrm((L, G, P, C), (2 * C) ** -0.5),
        "b_im": nrm((L, G, P, C), (2 * C) ** -0.5),
        "c_re": nrm((L, G, C, P), (2 * P) ** -0.5),
        "c_im": nrm((L, G, C, P), (2 * P) ** -0.5),
        "d_skip": nrm((L, W_B), 1.0),
        "w_glu": nrm((L, W_B, 2 * W_B), W_B ** -0.5),
        "b_glu": nrm((L, 2 * W_B), 0.02),
        "out_norm_a": gain((L, W_A)),
        "out_norm_b": gain((L, W_B)),
        "w_out": nrm((L, D_MIX, D), D_MIX ** -0.5),
        "norm2": gain((L, D)),
        "w_coarse": nrm((L, D, NG), D ** -0.5),
        "b_coarse": nrm((L, NG), 0.01),
        "w_fine": nrm((L, NG, D, EPG), D ** -0.5),
        "b_fine": nrm((L, NG, EPG), 0.01),
        "w_gate_e": nrm((L, NG, EPG, D, F), D ** -0.5),
        "w_up_e": nrm((L, NG, EPG, D, F), D ** -0.5),
        "w_down_e": nrm((L, NG, EPG, F, D), F ** -0.5),
        "norm3": gain((L, D)),
        "w_ple_gate": nrm((L, D, D), D ** -0.5),
        "w_ple_proj": nrm((L, PLE_DIM, D), PLE_DIM ** -0.5),
        "final_norm": gain((D,)),
    }


def reference(x, p, norm1, w_in, sgu_norm, w_spatial, b_spatial, a_re, a_im, log_dt,
              b_re, b_im, c_re, c_im, d_skip, w_glu, b_glu, out_norm_a, out_norm_b,
              w_out, norm2, w_coarse, b_coarse, w_fine, b_fine, w_gate_e, w_up_e,
              w_down_e, norm3, w_ple_gate, w_ple_proj, final_norm):
    h = x
    for i in range(DEPTH):
        hn = rmsnorm(h, norm1[i])
        proj = hn @ w_in[i]
        u = proj[..., :W_A]
        v = proj[..., W_A:2 * W_A]
        s = proj[..., 2 * W_A:]
        o_a = gmlp_mixer(u, v, sgu_norm[i], w_spatial[i], b_spatial[i])
        o_b = s5_mixer(s, a_re[i], a_im[i], log_dt[i], b_re[i], b_im[i], c_re[i], c_im[i],
                       d_skip[i], w_glu[i], b_glu[i])
        mix = jnp.concatenate([rmsnorm(o_a, out_norm_a[i]), rmsnorm(o_b, out_norm_b[i])], axis=-1)
        h = h + mix @ w_out[i]
        h = h + hier_moe(rmsnorm(h, norm2[i]), w_coarse[i], b_coarse[i], w_fine[i], b_fine[i],
                         w_gate_e[i], w_up_e[i], w_down_e[i])
        gate = jax.nn.sigmoid(rmsnorm(h, norm3[i]) @ w_ple_gate[i])
        h = h + gate * (p[i] @ w_ple_proj[i])
    return rmsnorm(h, final_norm)
```

```cpp
#include <hip/hip_runtime.h>
#include <cstdio>
#include <cstdint>

#ifndef MK_PER_PHASE
#define MK_PER_PHASE 0
#endif

#define LAS __attribute__((address_space(3)))
#define GAS __attribute__((address_space(1)))
typedef unsigned short bf16_t;
typedef short bf16x8 __attribute__((ext_vector_type(8)));
typedef float f32x4 __attribute__((ext_vector_type(4)));
typedef float f32x16 __attribute__((ext_vector_type(16)));
typedef unsigned u32x4 __attribute__((ext_vector_type(4)));
typedef unsigned u32x2 __attribute__((ext_vector_type(2)));

constexpr int M = 16384, D = 1024, WA = 512, WB = 512, NPROJ = 1536;
constexpr int SEQ = 4096;
constexpr int GCH = 128, HEADS = 8, DH = 64;
constexpr int SG = 32, SC = 16, SP = 64;
constexpr int SL = 32;
constexpr int NCHK = M / SL;
constexpr int CPB = SEQ / SL;
constexpr int KS5 = SL * SC + 2 * SP;
constexpr int NE = 32, FE = 256, EPG = 8, NGRP = 4;
constexpr int PLE = 256;
constexpr int SROWS = 2 * M + NE * 256;
constexpr float EPS = 1e-6f;

constexpr size_t MiB = 1u << 20;
constexpr size_t WS_CTL   = 0;
constexpr size_t CTL_ZERO = 65536;
constexpr size_t WS_STAT  = 1 * MiB;
constexpr size_t ST_VSS = WS_STAT;
constexpr size_t ST_OASS = ST_VSS + (size_t)M * 8 * 4;
constexpr size_t ST_OBSS = ST_OASS + (size_t)M * 16 * 4;
constexpr size_t ST_HSS = ST_OBSS + (size_t)M * 16 * 4;
constexpr size_t ST_FSS = ST_HSS + (size_t)M * 16 * 4;
constexpr size_t ST_R2 = ST_FSS + (size_t)M * 16 * 4;
constexpr size_t ST_R3 = ST_R2 + (size_t)M * 4;
constexpr size_t ST_RE = ST_R3 + (size_t)M * 4;
constexpr size_t ST_RW = ST_RE + (size_t)M * 8;
constexpr size_t ST_SLOT = ST_RW + (size_t)M * 8;
constexpr size_t ST_TOK = ST_SLOT + (size_t)M * 8;
constexpr size_t ST_SW = ST_TOK + (size_t)NE * M * 4;
constexpr size_t ST_SR2 = ST_SW + (size_t)SROWS * 4;
constexpr size_t ST_AL = ST_SR2 + (size_t)SROWS * 4;
constexpr size_t ST_END = ST_AL + (size_t)SG * SP * 8;
static_assert(ST_END <= 12 * MiB, "stats region");
constexpr size_t WS_WGU  = 12 * MiB;
constexpr size_t WS_WD   = WS_WGU + 32 * MiB;
constexpr size_t WS_WPG  = WS_WD + 16 * MiB;
constexpr size_t WS_WPP  = WS_WPG + 2 * MiB;
constexpr size_t WS_WIN  = WS_WPP + 1 * MiB;
constexpr size_t WS_WGLU = WS_WIN + 3 * MiB;
constexpr size_t WS_WOUT = WS_WGLU + 1 * MiB;
constexpr size_t WS_WM   = WS_WOUT + 2 * MiB;
constexpr size_t WS_WR   = WS_WM + 256 * 1024;
constexpr size_t WS_A0   = WS_WM + 1 * MiB;
constexpr size_t WS_PP   = WS_A0 + 32 * MiB;
constexpr size_t WS_LATE = WS_PP + 32 * MiB;
constexpr size_t WS_BT1  = WS_LATE;
constexpr size_t WS_BT2  = WS_BT1 + 8 * MiB;
constexpr size_t WS_MIX  = WS_BT2 + 20 * MiB;
constexpr size_t WS_Y2   = WS_MIX + 32 * MiB;
constexpr size_t WS_PB   = WS_Y2 + 16 * MiB;
constexpr size_t WS_XS   = WS_LATE;
constexpr size_t WS_END  = WS_LATE + 84 * MiB;
static_assert(WS_END <= 256 * MiB, "workspace");
constexpr size_t DO_UG = 0;
constexpr size_t DO_VG = 16 * MiB;
constexpr size_t DO_SH = 32 * MiB;
constexpr size_t DO_E  = 52 * MiB;
constexpr size_t DO_HB = 0;
constexpr size_t DO_HH = 32 * MiB;
constexpr int CW_BAR = 0;
constexpr int CW_CNT = 4096;

__device__ __forceinline__ float bf2f(unsigned v) { return __uint_as_float(v << 16); }
__device__ __forceinline__ unsigned f2bf(float f) { unsigned u = __float_as_uint(f); return (u + 0x7fffu + ((u >> 16) & 1u)) >> 16; }
__device__ __forceinline__ unsigned pk2(float lo, float hi) { unsigned r; asm volatile("v_cvt_pk_bf16_f32 %0, %1, %2" : "=v"(r) : "v"(lo), "v"(hi)); return r; }
__device__ __forceinline__ float lo16(unsigned w) { return __uint_as_float(w << 16); }
__device__ __forceinline__ float hi16(unsigned w) { return __uint_as_float(w & 0xffff0000u); }
__device__ __forceinline__ float sigmoidf_(float x) { return __builtin_amdgcn_rcpf(1.0f + __expf(-x)); }
__device__ __forceinline__ float gelu_t(float x) { const float u = x * (1.0f + 0.044715f * x * x); return x * __builtin_amdgcn_rcpf(1.0f + __expf(-1.5957691216057308f * u)); }
__device__ __forceinline__ float wave_sum(float v) {
#pragma unroll
    for (int o = 1; o < 64; o <<= 1) v += __shfl_xor(v, o);
    return v;
}
#define LDS_WAIT() asm volatile("s_waitcnt lgkmcnt(0)" ::: "memory")
#define VM_WAIT() asm volatile("s_waitcnt vmcnt(0)" ::: "memory")

namespace pg8 {
constexpr int BM = 256, BK = 64, HALF = 128, HTB = HALF * BK * 2, STAGE_BYTES = 8 * HTB, NXCD = 8, WGM = 8;
__host__ __device__ __forceinline__ int lds_byte(int r, int c) { const int st = (r >> 4) * 2 + (c >> 5), rr = r & 15, cc = c & 31, ob = rr * 64 + cc * 2; return st * 1024 + (ob ^ (((ob >> 9) & 1) << 5)); }
__host__ __device__ __forceinline__ void stage_rc(int b, int& R, int& C) { const int st = b / 1024, sb = b % 1024, swz = sb ^ (((sb >> 9) & 1) << 5); R = (st >> 1) * 16 + swz / 64; C = (st & 1) * 32 + (swz % 64) / 2; }
__host__ __device__ __forceinline__ int perm32(int rho) { const int n = rho >> 4, i = rho & 15; return 8 * (i >> 2) + 4 * n + (i & 3); }

struct Unit { const char* A; const char* B; int pm, pn, aux; };
struct Gemm { int lda, ldb, nt; };

struct DenseOrder {
    const char* A; const char* B; size_t tA, tB; int nM, nN, nwg, G, c;
    __device__ void init(const void* A_, int lda, const void* B_, int ldb, int Mr, int Nc, int G_, int c_) { A = (const char*)A_; B = (const char*)B_; tA = (size_t)BM * lda * 2; tB = (size_t)BM * ldb * 2; nM = Mr / BM; nN = Nc / BM; nwg = nM * nN; G = G_; c = c_; }
    __device__ bool next(int i, Unit& u) const {
        const long L = (long)i * G + c; if (L >= nwg) return false;
        int wgid = (int)L; { const int q = nwg / NXCD, r = nwg % NXCD, xcd = wgid % NXCD, off = wgid / NXCD; wgid = (xcd < r ? xcd * (q + 1) : r * (q + 1) + (xcd - r) * q) + off; }
        const int nig = WGM * nN, gid = wgid / nig, fm = gid * WGM, gsz = (nM - fm) < WGM ? (nM - fm) : WGM;
        u.pm = fm + ((wgid % nig) % gsz); u.pn = (wgid % nig) / gsz; u.aux = 0;
        u.A = A + (size_t)u.pm * tA; u.B = B + (size_t)u.pn * tB; return true;
    }
};

template <class Epi, class Sched, bool ALIGN_EPI, bool HOOK>
__device__ __forceinline__ void gemm_phase(LAS unsigned char* lds, const Gemm g, const Sched& S, const Epi& E) {
    const int tid = threadIdx.x, wid = __builtin_amdgcn_readfirstlane(tid >> 6), lane = tid & 63, wr = wid >> 2, wc = wid & 3, fr = lane & 15, fq = lane >> 4;
    int nt_ = g.nt; asm volatile("" : "+s"(nt_)); const int nt = nt_;
    unsigned voffA[2], voffB[2];
#pragma unroll
    for (int i = 0; i < 2; ++i) { int R, C; stage_rc(tid * 16 + i * 8192, R, C); const int Rb = Epi::PERM ? ((R & ~31) + perm32(R & 31)) : R;
        voffA[i] = (unsigned)(R * g.lda + C) * 2u; voffB[i] = (unsigned)(Rb * g.ldb + C) * 2u; }
    const size_t kstep = (size_t)(BK * 2);
    const size_t hstepA = (size_t)HALF * g.lda * 2, hstepB = (size_t)HALF * g.ldb * 2;
    const unsigned ldsw = (unsigned)wid * 1024u;
    const int aoff = lds_byte(wr * 64 + fr, fq * 8), boff = lds_byte(wc * 32 + fr, fq * 8);
#define PG8_SA(b, h) (((b) * 2 + (h)) * HTB)
#define PG8_SB(b, h) ((4 + (b) * 2 + (h)) * HTB)
#define PG8_STAGE(bufoff, gbase, voff) do { _Pragma("unroll") for (int _i = 0; _i < 2; ++_i) \
        __builtin_amdgcn_global_load_lds((const unsigned*)((const char*)(gbase) + (voff)[_i]), (LAS unsigned*)(lds + (bufoff) + ldsw + _i * 8192), 16, 0, 0); } while (0)
#define PG8_LDA(dst, b, h) do { _Pragma("unroll") for (int m = 0; m < 4; ++m) _Pragma("unroll") for (int k = 0; k < 2; ++k) dst[m][k] = *(const LAS bf16x8*)(lds + PG8_SA(b, h) + aoff + m * 2048 + k * 1024); } while (0)
#define PG8_LDB(dst, b, h) do { _Pragma("unroll") for (int n = 0; n < 2; ++n) _Pragma("unroll") for (int k = 0; k < 2; ++k) dst[n][k] = *(const LAS bf16x8*)(lds + PG8_SB(b, h) + boff + n * 2048 + k * 1024); } while (0)
#define PG8_MMA(ai, bj, At, Bt) do { __builtin_amdgcn_s_setprio(1); _Pragma("unroll") for (int m = 0; m < 4; ++m) _Pragma("unroll") for (int n = 0; n < 2; ++n) _Pragma("unroll") for (int k = 0; k < 2; ++k) \
        acc[ai][bj][m][n] = __builtin_amdgcn_mfma_f32_16x16x32_bf16(Bt[n][k], At[m][k], acc[ai][bj][m][n], 0, 0, 0); __builtin_amdgcn_s_setprio(0); } while (0)
#define PG8_WAIT_V(n) asm volatile("s_waitcnt vmcnt(" #n ")" ::: "memory")
#define PG8_WAIT_L(n) asm volatile("s_waitcnt lgkmcnt(" #n ")" ::: "memory")
#define PG8_BAR __builtin_amdgcn_s_barrier()
#define PG8_SCHED __builtin_amdgcn_sched_barrier(0)
    Unit cur, nxt; int ui = 0;
    if (!S.next(0, cur)) return;
    f32x4 acc[2][2][4][2];
#pragma unroll
    for (int a = 0; a < 2; ++a)
#pragma unroll
        for (int b = 0; b < 2; ++b)
#pragma unroll
            for (int m = 0; m < 4; ++m)
#pragma unroll
                for (int n = 0; n < 2; ++n) acc[a][b][m][n] = (f32x4){0.f, 0.f, 0.f, 0.f};
    bf16x8 At[4][2], B0[2][2], B1[2][2];
    const char* cA = cur.A; const char* cB = cur.B;
    PG8_STAGE(PG8_SB(0, 0), cB, voffB); PG8_STAGE(PG8_SB(0, 1), cB + hstepB, voffB); PG8_STAGE(PG8_SA(0, 0), cA, voffA); PG8_STAGE(PG8_SA(0, 1), cA + hstepA, voffA);
    if (wr == 1) PG8_BAR;
    PG8_WAIT_V(2); PG8_BAR;
    PG8_STAGE(PG8_SB(1, 0), cB + kstep, voffB); PG8_STAGE(PG8_SA(1, 0), cA + kstep, voffA); PG8_STAGE(PG8_SB(1, 1), cB + hstepB + kstep, voffB);
    PG8_WAIT_V(6); PG8_BAR;
    for (;;) {
        const bool has_next = S.next(ui + 1, nxt);
        const char* nA = has_next ? nxt.A : cA; const char* nB = has_next ? nxt.B : cB;
        for (int t = 0; t < nt; t += 2) {
            const bool last = (t == nt - 2);
            if constexpr (HOOK) { if (t == E.hook_t) E.mid(acc, wr, fr); }
            const char* a1 = cA + (size_t)(t + 1) * kstep;
            const char* a2 = last ? nA : cA + (size_t)(t + 2) * kstep; const char* b2 = last ? nB : cB + (size_t)(t + 2) * kstep;
            const char* a3 = a2 + kstep; const char* b3 = b2 + kstep;
            PG8_LDB(B0, 0, 0); PG8_LDB(B1, 0, 1); PG8_SCHED; PG8_LDA(At, 0, 0); PG8_STAGE(PG8_SA(1, 1), a1 + hstepA, voffA);
            PG8_WAIT_V(8); PG8_WAIT_L(0); PG8_BAR; PG8_MMA(0, 0, At, B0); PG8_MMA(0, 1, At, B1); PG8_BAR; PG8_SCHED;
            PG8_LDA(At, 0, 1); PG8_STAGE(PG8_SB(0, 0), b2, voffB); PG8_STAGE(PG8_SB(0, 1), b2 + hstepB, voffB); PG8_STAGE(PG8_SA(0, 0), a2, voffA);
            PG8_WAIT_V(8); PG8_WAIT_L(0); PG8_BAR; PG8_MMA(1, 0, At, B0); PG8_MMA(1, 1, At, B1); PG8_BAR; PG8_SCHED;
            PG8_LDB(B0, 1, 0); PG8_LDB(B1, 1, 1); PG8_SCHED; PG8_LDA(At, 1, 0); PG8_STAGE(PG8_SA(0, 1), a2 + hstepA, voffA);
            PG8_WAIT_V(8); PG8_WAIT_L(0); PG8_BAR; PG8_MMA(0, 0, At, B0); PG8_MMA(0, 1, At, B1); PG8_BAR; PG8_SCHED;
            PG8_LDA(At, 1, 1); PG8_STAGE(PG8_SB(1, 0), b3, voffB); PG8_STAGE(PG8_SB(1, 1), b3 + hstepB, voffB); PG8_STAGE(PG8_SA(1, 0), a3, voffA);
            PG8_WAIT_V(8); PG8_WAIT_L(0); PG8_BAR; PG8_MMA(1, 0, At, B0); PG8_MMA(1, 1, At, B1); PG8_BAR; PG8_SCHED;
        }
        if constexpr (ALIGN_EPI) { if (wr == 0) PG8_BAR; }
        E(acc, cur, wr, wc, fr, fq);
        if (!has_next) break;
#pragma unroll
        for (int a = 0; a < 2; ++a)
#pragma unroll
            for (int b = 0; b < 2; ++b)
#pragma unroll
                for (int m = 0; m < 4; ++m)
#pragma unroll
                    for (int n = 0; n < 2; ++n) acc[a][b][m][n] = (f32x4){0.f, 0.f, 0.f, 0.f};
        cur = nxt; cA = nA; cB = nB; ++ui;
        if constexpr (ALIGN_EPI) { if (wr == 1) PG8_BAR; }
    }
    PG8_WAIT_V(0);
    if constexpr (!ALIGN_EPI) { if (wr == 0) PG8_BAR; }
    PG8_BAR;
#undef PG8_SA
#undef PG8_SB
#undef PG8_STAGE
#undef PG8_LDA
#undef PG8_LDB
#undef PG8_MMA
#undef PG8_WAIT_V
#undef PG8_WAIT_L
#undef PG8_BAR
#undef PG8_SCHED
}
}
using pg8::Unit;

#define XB_TMO      128
#define XB_XCNT(j)  (256  + 64 * (j))
#define XB_XSUB(j)  (1280 + 64 * (j))
#define XB_XGEN(j)  (2304 + 64 * (j))
#define XB_TOP      3328
#define XB_TOPGEN   3392
#define XCD_BAR_WORDS 3456
#define XB_SPIN_CAP (1u << 18)
__device__ __forceinline__ unsigned xb_ld(unsigned* p)              { return __hip_atomic_load(p, __ATOMIC_RELAXED, __HIP_MEMORY_SCOPE_AGENT); }
__device__ __forceinline__ unsigned xb_add(unsigned* p, unsigned v) { return __hip_atomic_fetch_add(p, v, __ATOMIC_RELAXED, __HIP_MEMORY_SCOPE_AGENT); }
__device__ __forceinline__ unsigned xb_xcc_id() { return (unsigned)__builtin_amdgcn_s_getreg((3 << 11) | 20) & 0xFu; }
#define XB_SPIN(cond, bar) do { unsigned _sp = 0; while (cond) { __builtin_amdgcn_s_sleep(1); \
    if ((++_sp & 255u) == 0u) { if (xb_ld(&(bar)[XB_TMO])) break; if (_sp > XB_SPIN_CAP) { atomicAdd(&(bar)[XB_TMO], 1u); break; } } } } while (0)
struct XcdBarrier { unsigned* bar; unsigned x; volatile LAS unsigned* st; };
__device__ __forceinline__ XcdBarrier xcd_barrier_post(unsigned* bar, volatile LAS unsigned* st) {
    XcdBarrier b; b.bar = bar; b.x = xb_xcc_id(); b.st = st;
    if (threadIdx.x == 0) (void)xb_add(&bar[XB_XCNT(b.x)], 1u);
    return b;
}
__device__ __forceinline__ void xcd_barrier_complete(unsigned* bar, unsigned x, unsigned& nloc, unsigned& nx) {
    const unsigned G = gridDim.x * gridDim.y * gridDim.z;
    unsigned sum, cnt, mine, sp = 0u;
    for (;;) {
        sum = 0u; cnt = 0u; mine = 0u;
#pragma unroll
        for (unsigned j = 0; j < 16; ++j) { const unsigned c = xb_ld(&bar[XB_XCNT(j)]); sum += c; cnt += (c > 0u) ? 1u : 0u; mine = (j == x) ? c : mine; }
        if (sum == G) break;
        __builtin_amdgcn_s_sleep(1);
        if ((++sp & 255u) == 0u) { if (xb_ld(&bar[XB_TMO])) break; if (sp > XB_SPIN_CAP) { atomicAdd(&bar[XB_TMO], 1u); break; } }
    }
    nloc = mine > 0u ? mine : 1u; nx = cnt > 0u ? cnt : 1u;
}
__device__ __forceinline__ void xcd_barrier(const XcdBarrier& b) {
    asm volatile("s_waitcnt vmcnt(0)" ::: "memory");
    __syncthreads();
    if (threadIdx.x == 0) {
        unsigned* bar = b.bar;
        __builtin_amdgcn_s_waitcnt(0);
        unsigned nloc = b.st[0], nx = b.st[1];
        if (nloc == 0u) { xcd_barrier_complete(bar, b.x, nloc, nx); b.st[0] = nloc; b.st[1] = nx; }
        const unsigned old = xb_add(&bar[XB_XSUB(b.x)], 1u);
        const unsigned gen = old / nloc;
        if (old + 1u == (gen + 1u) * nloc) {
            __builtin_amdgcn_fence(__ATOMIC_RELEASE, "agent");
            asm volatile("s_waitcnt vmcnt(0)" ::: "memory");
            const unsigned og = xb_add(&bar[XB_TOP], 1u);
            const unsigned tg = og / nx;
            if (og + 1u == (tg + 1u) * nx) xb_add(&bar[XB_TOPGEN], 1u);
            else XB_SPIN(xb_ld(&bar[XB_TOPGEN]) == tg, bar);
            __builtin_amdgcn_fence(__ATOMIC_ACQUIRE, "agent");
            xb_add(&bar[XB_XGEN(b.x)], 1u);
            asm volatile("s_waitcnt vmcnt(0)" ::: "memory");
        } else {
            XB_SPIN(xb_ld(&bar[XB_XGEN(b.x)]) == gen, bar);
            __builtin_amdgcn_fence(__ATOMIC_ACQUIRE, "agent");
            asm volatile("s_waitcnt vmcnt(0)" ::: "memory");
        }
    }
    __syncthreads();
}

constexpr int NWAVES = 8, NTHR = 512;
constexpr int RING_BYTES = 131072;
constexpr int AUX_OFF = RING_BYTES;
constexpr int AUX_MISC = AUX_OFF;
constexpr int AUX_RA = AUX_OFF + 256;
constexpr int AUX_RB = AUX_RA + 1024;
constexpr int AUX_TB = AUX_RB + 1024;
constexpr int LDS_BYTES = 147456;

struct Args { const float* in[32]; float* out; unsigned char* ws; int ph_lo, ph_hi; };

struct Frame {
    LAS unsigned char* lds;
    int tid, lane, wave, G, bid;
    unsigned char* ws; unsigned char* dout;
};
#define WSP(T, off) ((T*)(F.ws + (off)))
#define DOP(T, off) ((T*)(F.dout + (off)))

__device__ __forceinline__ void transpose_item(const float* W, int ldw, int k0, int n0, const float* kscale, bf16_t* WT, int ldt, int dst_row0, LAS float* scr, int lane) {
#pragma unroll 8
    for (int i = 0; i < 32; ++i) { const int kk = 2 * i + (lane >> 5); float v = W[(size_t)(k0 + kk) * ldw + n0 + (lane & 31)]; if (kscale) v *= kscale[k0 + kk]; scr[kk * 33 + (lane & 31)] = v; }
    LDS_WAIT(); asm volatile("" ::: "memory");
    const int c = lane & 7;
#pragma unroll
    for (int j = 0; j < 4; ++j) { const int n = (lane >> 3) + 8 * j; const LAS float* s = scr + (8 * c) * 33 + n;
        u32x4 o; o.x = pk2(s[0 * 33], s[1 * 33]); o.y = pk2(s[2 * 33], s[3 * 33]); o.z = pk2(s[4 * 33], s[5 * 33]); o.w = pk2(s[6 * 33], s[7 * 33]);
        *(u32x4*)(WT + (size_t)(dst_row0 + n) * ldt + k0 + 8 * c) = o; }
    LDS_WAIT(); asm volatile("" ::: "memory");
}

__device__ __forceinline__ void s5_precompute(const Args& args, Frame& F, int g, int part) {
    LAS float* pwr = (LAS float*)F.lds;
    LAS float* pwi = pwr + 64 * 33;
    LAS float* bbr = pwi + 64 * 33;
    LAS float* bbi = bbr + 64 * 16;
    LAS float* ccr = bbi + 64 * 16;
    LAS float* cci = ccr + 64 * 16;
    LAS float* Kt = cci + 64 * 16;
    const float* a_re = args.in[7]; const float* a_im = args.in[8]; const float* log_dt = args.in[9];
    const float* b_re = args.in[10]; const float* b_im = args.in[11]; const float* c_re = args.in[12]; const float* c_im = args.in[13];
    const int tid = F.tid;
    if (tid < 64) {
        const int p = tid;
        const float dt = __expf(log_dt[g]);
        const float lr = a_re[g * SP + p], li = a_im[g * SP + p];
        const float mag = __expf(lr * dt);
        const double ph = (double)li * (double)dt; const double phr = ph - 6.283185307179586 * __builtin_rint(ph * 0.15915494309189535);
        const float sn = sinf((float)phr), cs = cosf((float)phr);
        const float ar = mag * cs, ai = mag * sn;
        const float nr = ar - 1.0f, ni = ai; const float den = lr * lr + li * li;
        const float cr = (nr * lr + ni * li) / den, ci = (ni * lr - nr * li) / den;
        double xr = 1.0, xi = 0.0;
        for (int k = 0; k <= 32; ++k) { pwr[p * 33 + k] = (float)xr; pwi[p * 33 + k] = (float)xi; const double t = xr * ar - xi * ai; xi = xr * ai + xi * ar; xr = t; }
        for (int c = 0; c < 16; ++c) { const float br = b_re[(g * SP + p) * SC + c], bi = b_im[(g * SP + p) * SC + c]; bbr[p * 16 + c] = cr * br - ci * bi; bbi[p * 16 + c] = cr * bi + ci * br; }
        for (int c = 0; c < 16; ++c) { ccr[p * 16 + c] = c_re[(g * SC + c) * SP + p]; cci[p * 16 + c] = c_im[(g * SC + c) * SP + p]; }
        if (part == 0) { float* AL = WSP(float, ST_AL); AL[(g * SP + p) * 2] = pwr[p * 33 + 32]; AL[(g * SP + p) * 2 + 1] = pwi[p * 33 + 32]; }
    }
    __syncthreads();
    {
        const int k = tid >> 4, co = tid & 15;
        float acc[16];
#pragma unroll
        for (int i = 0; i < 16; ++i) acc[i] = 0.f;
        for (int p = 0; p < 64; ++p) {
            const float cr = ccr[p * 16 + co], ci = cci[p * 16 + co], pr = pwr[p * 33 + k], pi = pwi[p * 33 + k];
            const float xr = cr * pr - ci * pi, xi = cr * pi + ci * pr;
#pragma unroll
            for (int i = 0; i < 16; ++i) acc[i] += xr * bbr[p * 16 + i] - xi * bbi[p * 16 + i];
        }
#pragma unroll
        for (int i = 0; i < 16; ++i) Kt[(k * 16 + co) * 16 + i] = acc[i];
    }
    __syncthreads();
    bf16_t* BT2 = WSP(bf16_t, WS_BT2) + (size_t)g * 512 * KS5;
    for (int q = tid; q < 64 * 80; q += NTHR) {
        const int n = part * 64 + q / 80, ch = q % 80, tp = n >> 4, co = n & 15;
        float v[8];
        if (ch < 64) { const int tau = ch >> 1, ci0 = (ch & 1) * 8;
#pragma unroll
            for (int j = 0; j < 8; ++j) v[j] = (tau <= tp) ? Kt[((tp - tau) * 16 + co) * 16 + ci0 + j] : 0.f;
        } else { const int q0 = (ch - 64) * 8;
#pragma unroll
            for (int j = 0; j < 8; ++j) { const int qq = q0 + j, p = qq & 63; const float cr = ccr[p * 16 + co], ci = cci[p * 16 + co], pr = pwr[p * 33 + tp + 1], pi = pwi[p * 33 + tp + 1];
                v[j] = (qq < 64) ? (cr * pr - ci * pi) : -(cr * pi + ci * pr); }
        }
        u32x4 o; o.x = pk2(v[0], v[1]); o.y = pk2(v[2], v[3]); o.z = pk2(v[4], v[5]); o.w = pk2(v[6], v[7]);
        *(u32x4*)(BT2 + (size_t)n * KS5 + ch * 8) = o;
    }
    bf16_t* BT1 = WSP(bf16_t, WS_BT1) + (size_t)g * 256 * 512;
    for (int q = tid; q < 32 * 64; q += NTHR) {
        const int n = part * 32 + q / 64, ch = q % 64, tau = ch >> 1, ci0 = (ch & 1) * 8;
        float v[8];
#pragma unroll
        for (int j = 0; j < 8; ++j) {
            if (n < 128) { const int p = n & 63; const float pr = pwr[p * 33 + 31 - tau], pi = pwi[p * 33 + 31 - tau], br = bbr[p * 16 + ci0 + j], bi = bbi[p * 16 + ci0 + j];
                v[j] = (n < 64) ? (pr * br - pi * bi) : (pr * bi + pi * br); }
            else v[j] = 0.f;
        }
        u32x4 o; o.x = pk2(v[0], v[1]); o.y = pk2(v[2], v[3]); o.z = pk2(v[4], v[5]); o.w = pk2(v[6], v[7]);
        *(u32x4*)(BT1 + (size_t)n * 512 + ch * 8) = o;
    }
    __syncthreads();
}

__device__ __forceinline__ void p0_prologue(const Args& args, Frame& F) {
    for (int u = F.bid; u < SG * 8; u += F.G) s5_precompute(args, F, u >> 3, u & 7);
    LAS float* scr = (LAS float*)(F.lds + F.wave * 16384);
    const int gw = F.bid * NWAVES + F.wave, NGW = F.G * NWAVES;
    constexpr int I_IN = 16 * 48, I_GLU = 8 * 32, I_OUT = 16 * 32, I_GATE = NE * 128, I_UP = NE * 128, I_DOWN = NE * 128, I_PG = 16 * 32, I_PPJ = 4 * 32;
    constexpr int NITEMS = I_IN + I_GLU + I_OUT + I_GATE + I_UP + I_DOWN + I_PG + I_PPJ;
    for (int it = gw; it < NITEMS; it += NGW) {
        int r = it;
        if (r < I_IN) { const int kb = r / 48, nb = r % 48; transpose_item(args.in[3], NPROJ, kb * 64, nb * 32, nullptr, WSP(bf16_t, WS_WIN), D, nb * 32, scr, F.lane); continue; } r -= I_IN;
        if (r < I_GLU) { const int kb = r / 32, nb = r % 32, c0 = nb * 32; const int dst = (c0 < 512) ? ((c0 >> 7) * 256 + (c0 & 127)) : ((((c0 - 512) >> 7)) * 256 + 128 + ((c0 - 512) & 127));
            transpose_item(args.in[15], 2 * WB, kb * 64, c0, nullptr, WSP(bf16_t, WS_WGLU), WB, dst, scr, F.lane); continue; } r -= I_GLU;
        if (r < I_OUT) { const int kb = r / 32, nb = r % 32; const float* ks = (kb < 8) ? args.in[17] : (args.in[18] - 512);
            transpose_item(args.in[19], D, kb * 64, nb * 32, ks, WSP(bf16_t, WS_WOUT), D, nb * 32, scr, F.lane); continue; } r -= I_OUT;
        if (r < I_GATE) { const int e = r / 128, q = r % 128, kb = q / 8, nb = q % 8, f0 = nb * 32; const int dst = (f0 >> 7) * 256 + (f0 & 127);
            transpose_item(args.in[25] + (size_t)e * D * FE, FE, kb * 64, f0, args.in[20], WSP(bf16_t, WS_WGU) + (size_t)e * 512 * D, D, dst, scr, F.lane); continue; } r -= I_GATE;
        if (r < I_UP) { const int e = r / 128, q = r % 128, kb = q / 8, nb = q % 8, f0 = nb * 32; const int dst = (f0 >> 7) * 256 + 128 + (f0 & 127);
            transpose_item(args.in[26] + (size_t)e * D * FE, FE, kb * 64, f0, args.in[20], WSP(bf16_t, WS_WGU) + (size_t)e * 512 * D, D, dst, scr, F.lane); continue; } r -= I_UP;
        if (r < I_DOWN) { const int e = r / 128, q = r % 128, kb = q / 32, nb = q % 32;
            transpose_item(args.in[27] + (size_t)e * FE * D, D, kb * 64, nb * 32, nullptr, WSP(bf16_t, WS_WD) + (size_t)e * D * FE, FE, nb * 32, scr, F.lane); continue; } r -= I_DOWN;
        if (r < I_PG) { const int kb = r / 32, nb = r % 32; transpose_item(args.in[29], D, kb * 64, nb * 32, args.in[28], WSP(bf16_t, WS_WPG), D, nb * 32, scr, F.lane); continue; } r -= I_PG;
        { const int kb = r / 32, nb = r % 32; transpose_item(args.in[30], D, kb * 64, nb * 32, nullptr, WSP(bf16_t, WS_WPP), PLE, nb * 32, scr, F.lane); }
    }
    const int gt = F.bid * NTHR + F.tid, NGT = F.G * NTHR;
    { bf16_t* WR = WSP(bf16_t, WS_WR); const float* wc = args.in[21]; const float* wf = args.in[23]; const float* g2 = args.in[20];
      for (int i = gt; i < 64 * D; i += NGT) { const int j = i >> 10, k = i & 1023; float v = 0.f;
          if (j < 4) v = wc[k * 4 + j]; else if (j < 36) { const int gg = (j - 4) >> 3, e = (j - 4) & 7; v = wf[((size_t)gg * D + k) * 8 + e]; }
          WR[i] = (bf16_t)f2bf(v * g2[k]); } }
    { bf16_t* WM = WSP(bf16_t, WS_WM); const float* wsp = args.in[5];
      for (int i = gt; i < HEADS * GCH * GCH; i += NGT) { const int t = (i >> 7) & 127, s = i & 127; WM[i] = (bf16_t)f2bf(s <= t ? wsp[i] : 0.f); } }
    { const f32x4* pp = (const f32x4*)args.in[1]; u32x2* PB = WSP(u32x2, WS_PB);
      for (int i = gt; i < M * PLE / 4; i += NGT) { const f32x4 v = pp[i]; u32x2 o; o.x = pk2(v.x, v.y); o.y = pk2(v.z, v.w); PB[i] = o; } }
    { const float* x = args.in[0]; const float* g1 = args.in[2]; bf16_t* XN = WSP(bf16_t, WS_A0);
      f32x4 gv[4];
#pragma unroll
      for (int j = 0; j < 4; ++j) gv[j] = ((const f32x4*)g1)[F.lane + 64 * j];
      for (int m = gw; m < M; m += NGW) {
          const f32x4* xr = (const f32x4*)(x + (size_t)m * D) + F.lane; f32x4 v[4]; float s = 0.f;
#pragma unroll
          for (int j = 0; j < 4; ++j) { v[j] = xr[64 * j]; s += (v[j].x * v[j].x + v[j].y * v[j].y) + (v[j].z * v[j].z + v[j].w * v[j].w); }
          const float r = rsqrtf(wave_sum(s) * (1.f / D) + EPS);
          u32x2* o8 = (u32x2*)(XN + (size_t)m * D) + F.lane;
#pragma unroll
          for (int j = 0; j < 4; ++j) { u32x2 o; o.x = pk2(v[j].x * r * gv[j].x, v[j].y * r * gv[j].y); o.y = pk2(v[j].z * r * gv[j].z, v[j].w * r * gv[j].w); o8[64 * j] = o; }
      } }
}

typedef f32x4 AccT[2][2][4][2];
struct EpiProj {
    static constexpr bool PERM = true; static constexpr int hook_t = -1;
    bf16_t* UG; bf16_t* VG; bf16_t* SH; float* VSS;
    __device__ __forceinline__ void mid(AccT&, int, int) const {}
    __device__ __forceinline__ void operator()(const AccT& acc, const Unit& u, int wr, int wc, int fr, int fq) const {
        const int kind = u.pn >> 1, cb = (u.pn & 1) * 256;
#pragma unroll
        for (int ai = 0; ai < 2; ++ai)
#pragma unroll
            for (int m = 0; m < 4; ++m) {
                const int row = u.pm * 256 + ai * 128 + wr * 64 + m * 16 + fr; float ss = 0.f;
#pragma unroll
                for (int bj = 0; bj < 2; ++bj) {
                    const int col = cb + bj * 128 + wc * 32 + fq * 8; f32x4 v0 = acc[ai][bj][m][0], v1 = acc[ai][bj][m][1];
                    if (kind < 2) {
                        v0 = (f32x4){gelu_t(v0[0]), gelu_t(v0[1]), gelu_t(v0[2]), gelu_t(v0[3])}; v1 = (f32x4){gelu_t(v1[0]), gelu_t(v1[1]), gelu_t(v1[2]), gelu_t(v1[3])};
                        ss += (v0[0] * v0[0] + v0[1] * v0[1]) + (v0[2] * v0[2] + v0[3] * v0[3]) + (v1[0] * v1[0] + v1[1] * v1[1]) + (v1[2] * v1[2] + v1[3] * v1[3]);
                    }
                    u32x4 w; w.x = pk2(v0[0], v0[1]); w.y = pk2(v0[2], v0[3]); w.z = pk2(v1[0], v1[1]); w.w = pk2(v1[2], v1[3]);
                    if (kind == 0) *(u32x4*)(UG + (size_t)row * WA + col) = w;
                    else if (kind == 1) *(u32x4*)(VG + (size_t)row * WA + col) = w;
                    else { const int g = col >> 4, ci0 = col & 15; *(u32x4*)(SH + ((size_t)(g * NCHK + (row >> 5)) * KS5 + (row & 31) * 16 + ci0)) = w; }
                }
                if (kind == 1) { ss += __shfl_xor(ss, 16); ss += __shfl_xor(ss, 32); if (fq == 0) VSS[row * 8 + (u.pn & 1) * 4 + wc] = ss; }
            }
    }
};
struct EpiS5a {
    static constexpr bool PERM = false; static constexpr int hook_t = -1;
    float* E;
    __device__ __forceinline__ void mid(AccT&, int, int) const {}
    __device__ __forceinline__ void operator()(const AccT& acc, const Unit& u, int wr, int wc, int fr, int fq) const {
#pragma unroll
        for (int ai = 0; ai < 2; ++ai)
#pragma unroll
            for (int m = 0; m < 4; ++m) { const int r = u.pm * 256 + ai * 128 + wr * 64 + m * 16 + fr; float* rowp = E + ((size_t)u.aux * NCHK + r) * 128 + wc * 32 + fq * 4;
#pragma unroll
                for (int n = 0; n < 2; ++n) *(f32x4*)(rowp + n * 16) = acc[ai][0][m][n]; }
    }
};
struct EpiS5b {
    static constexpr bool PERM = true; static constexpr int hook_t = -1;
    const bf16_t* SH; const float* dskip; bf16_t* Y2;
    __device__ __forceinline__ void mid(AccT&, int, int) const {}
    __device__ __forceinline__ void operator()(const AccT& acc, const Unit& u, int wr, int wc, int fr, int fq) const {
        const int g = u.aux;
#pragma unroll
        for (int bj = 0; bj < 2; ++bj) {
            const int n = u.pn * 256 + bj * 128 + wc * 32 + fq * 8, tp = n >> 4, co0 = n & 15;
            const f32x4 d0 = *(const f32x4*)(dskip + g * 16 + co0), d1 = *(const f32x4*)(dskip + g * 16 + co0 + 4);
#pragma unroll
            for (int ai = 0; ai < 2; ++ai)
#pragma unroll
                for (int m = 0; m < 4; ++m) {
                    const int r = u.pm * 256 + ai * 128 + wr * 64 + m * 16 + fr;
                    const u32x4 sv = *(const u32x4*)(SH + ((size_t)(g * NCHK + r) * KS5 + n));
                    const f32x4 v0 = acc[ai][bj][m][0], v1 = acc[ai][bj][m][1];
                    u32x4 w;
                    w.x = pk2(gelu_t(v0[0] + d0[0] * lo16(sv.x)), gelu_t(v0[1] + d0[1] * hi16(sv.x)));
                    w.y = pk2(gelu_t(v0[2] + d0[2] * lo16(sv.y)), gelu_t(v0[3] + d0[3] * hi16(sv.y)));
                    w.z = pk2(gelu_t(v1[0] + d1[0] * lo16(sv.z)), gelu_t(v1[1] + d1[1] * hi16(sv.z)));
                    w.w = pk2(gelu_t(v1[2] + d1[2] * lo16(sv.w)), gelu_t(v1[3] + d1[3] * hi16(sv.w)));
                    *(u32x4*)(Y2 + ((size_t)(r * SL + tp) * WB + g * 16 + co0)) = w;
                }
        }
    }
};
struct EpiGlu {
    static constexpr bool PERM = true; static constexpr int hook_t = -1;
    const float* bglu; bf16_t* MIX; float* OBSS;
    __device__ __forceinline__ void mid(AccT&, int, int) const {}
    __device__ __forceinline__ void operator()(const AccT& acc, const Unit& u, int wr, int wc, int fr, int fq) const {
        const int col = u.pn * 128 + wc * 32 + fq * 8;
        const f32x4 bv0 = *(const f32x4*)(bglu + col), bv1 = *(const f32x4*)(bglu + col + 4), bg0 = *(const f32x4*)(bglu + 512 + col), bg1 = *(const f32x4*)(bglu + 512 + col + 4);
#pragma unroll
        for (int ai = 0; ai < 2; ++ai)
#pragma unroll
            for (int m = 0; m < 4; ++m) {
                const int row = u.pm * 256 + ai * 128 + wr * 64 + m * 16 + fr;
                const f32x4 a0 = acc[ai][0][m][0] + bv0, a1 = acc[ai][0][m][1] + bv1, g0 = acc[ai][1][m][0] + bg0, g1 = acc[ai][1][m][1] + bg1;
                float o[8];
#pragma unroll
                for (int j = 0; j < 4; ++j) { o[j] = a0[j] * sigmoidf_(g0[j]); o[4 + j] = a1[j] * sigmoidf_(g1[j]); }
                float ss = 0.f;
#pragma unroll
                for (int j = 0; j < 8; ++j) ss += o[j] * o[j];
                u32x4 w; w.x = pk2(o[0], o[1]); w.y = pk2(o[2], o[3]); w.z = pk2(o[4], o[5]); w.w = pk2(o[6], o[7]);
                *(u32x4*)(MIX + (size_t)row * D + 512 + col) = w;
                ss += __shfl_xor(ss, 16); ss += __shfl_xor(ss, 32); if (fq == 0) OBSS[row * 16 + u.pn * 4 + wc] = ss;
            }
    }
};
struct EpiOut {
    static constexpr bool PERM = true; static constexpr int hook_t = 8;
    const float* x; bf16_t* HB; float* HSS; const LAS float* ra; const LAS float* rb;
    __device__ __forceinline__ void mid(AccT& acc, int wr, int fr) const {
#pragma unroll
        for (int ai = 0; ai < 2; ++ai)
#pragma unroll
            for (int m = 0; m < 4; ++m) { const int rl = ai * 128 + wr * 64 + m * 16 + fr; const float f = ra[rl] / rb[rl];
#pragma unroll
                for (int bj = 0; bj < 2; ++bj)
#pragma unroll
                    for (int n = 0; n < 2; ++n) acc[ai][bj][m][n] = acc[ai][bj][m][n] * f; }
    }
    __device__ __forceinline__ void operator()(const AccT& acc, const Unit& u, int wr, int wc, int fr, int fq) const {
#pragma unroll
        for (int ai = 0; ai < 2; ++ai)
#pragma unroll
            for (int m = 0; m < 4; ++m) {
                const int rl = ai * 128 + wr * 64 + m * 16 + fr, row = u.pm * 256 + rl; const float f = rb[rl]; float ss = 0.f;
#pragma unroll
                for (int bj = 0; bj < 2; ++bj) {
                    const int col = u.pn * 256 + bj * 128 + wc * 32 + fq * 8;
                    const f32x4 x0 = *(const f32x4*)(x + (size_t)row * D + col), x1 = *(const f32x4*)(x + (size_t)row * D + col + 4);
                    const f32x4 h0 = x0 + acc[ai][bj][m][0] * f, h1 = x1 + acc[ai][bj][m][1] * f;
                    ss += (h0[0] * h0[0] + h0[1] * h0[1]) + (h0[2] * h0[2] + h0[3] * h0[3]) + (h1[0] * h1[0] + h1[1] * h1[1]) + (h1[2] * h1[2] + h1[3] * h1[3]);
                    u32x4 w; w.x = pk2(h0[0], h0[1]); w.y = pk2(h0[2], h0[3]); w.z = pk2(h1[0], h1[1]); w.w = pk2(h1[2], h1[3]);
                    *(u32x4*)(HB + (size_t)row * D + col) = w;
                }
                ss += __shfl_xor(ss, 16); ss += __shfl_xor(ss, 32); if (fq == 0) HSS[row * 16 + u.pn * 4 + wc] = ss;
            }
    }
};
struct EpiBf {
    static constexpr bool PERM = true; static constexpr int hook_t = -1;
    bf16_t* O; int ldc;
    __device__ __forceinline__ void mid(AccT&, int, int) const {}
    __device__ __forceinline__ void operator()(const AccT& acc, const Unit& u, int wr, int wc, int fr, int fq) const {
#pragma unroll
        for (int ai = 0; ai < 2; ++ai)
#pragma unroll
            for (int m = 0; m < 4; ++m) { const int row = u.pm * 256 + ai * 128 + wr * 64 + m * 16 + fr;
#pragma unroll
                for (int bj = 0; bj < 2; ++bj) { const int col = u.pn * 256 + bj * 128 + wc * 32 + fq * 8; const f32x4 v0 = acc[ai][bj][m][0], v1 = acc[ai][bj][m][1];
                    u32x4 w; w.x = pk2(v0[0], v0[1]); w.y = pk2(v0[2], v0[3]); w.z = pk2(v1[0], v1[1]); w.w = pk2(v1[2], v1[3]);
                    *(u32x4*)(O + (size_t)row * ldc + col) = w; } }
    }
};
struct EpiGU {
    static constexpr bool PERM = true; static constexpr int hook_t = -1;
    const float* SR2; bf16_t* HH;
    __device__ __forceinline__ void mid(AccT&, int, int) const {}
    __device__ __forceinline__ void operator()(const AccT& acc, const Unit& u, int wr, int wc, int fr, int fq) const {
        const int col = u.pn * 128 + wc * 32 + fq * 8;
#pragma unroll
        for (int ai = 0; ai < 2; ++ai)
#pragma unroll
            for (int m = 0; m < 4; ++m) { const int row = u.pm * 256 + ai * 128 + wr * 64 + m * 16 + fr; const float r2 = SR2[row];
                const f32x4 g0 = acc[ai][0][m][0] * r2, g1 = acc[ai][0][m][1] * r2, u0 = acc[ai][1][m][0] * r2, u1 = acc[ai][1][m][1] * r2;
                float o[8];
#pragma unroll
                for (int j = 0; j < 4; ++j) { o[j] = g0[j] * sigmoidf_(g0[j]) * u0[j]; o[4 + j] = g1[j] * sigmoidf_(g1[j]) * u1[j]; }
                u32x4 w; w.x = pk2(o[0], o[1]); w.y = pk2(o[2], o[3]); w.z = pk2(o[4], o[5]); w.w = pk2(o[6], o[7]);
                *(u32x4*)(HH + (size_t)row * FE + col) = w; }
    }
};
struct EpiDown {
    static constexpr bool PERM = true; static constexpr int hook_t = -1;
    const float* SW; bf16_t* YE;
    __device__ __forceinline__ void mid(AccT&, int, int) const {}
    __device__ __forceinline__ void operator()(const AccT& acc, const Unit& u, int wr, int wc, int fr, int fq) const {
#pragma unroll
        for (int ai = 0; ai < 2; ++ai)
#pragma unroll
            for (int m = 0; m < 4; ++m) { const int row = u.pm * 256 + ai * 128 + wr * 64 + m * 16 + fr; const float wgt = SW[row];
#pragma unroll
                for (int bj = 0; bj < 2; ++bj) { const int col = u.pn * 256 + bj * 128 + wc * 32 + fq * 8; const f32x4 v0 = acc[ai][bj][m][0] * wgt, v1 = acc[ai][bj][m][1] * wgt;
                    u32x4 w; w.x = pk2(v0[0], v0[1]); w.y = pk2(v0[2], v0[3]); w.z = pk2(v1[0], v1[1]); w.w = pk2(v1[2], v1[3]);
                    *(u32x4*)(YE + (size_t)row * D + col) = w; } }
    }
};
struct EpiPle {
    static constexpr bool PERM = false; static constexpr int hook_t = -1;
    const bf16_t* H2B; const bf16_t* PP; const float* R3; float* out; float* FSS;
    __device__ __forceinline__ void mid(AccT&, int, int) const {}
    __device__ __forceinline__ void operator()(const AccT& acc, const Unit& u, int wr, int wc, int fr, int fq) const {
#pragma unroll
        for (int ai = 0; ai < 2; ++ai)
#pragma unroll
            for (int m = 0; m < 4; ++m) { const int row = u.pm * 256 + ai * 128 + wr * 64 + m * 16 + fr; const float r3 = R3[row]; float ss = 0.f;
#pragma unroll
                for (int bj = 0; bj < 2; ++bj)
#pragma unroll
                    for (int n = 0; n < 2; ++n) { const int col = u.pn * 256 + bj * 128 + wc * 32 + n * 16 + fq * 4; const size_t off = (size_t)row * D + col;
                        const u32x2 hv = *(const u32x2*)(H2B + off), pv = *(const u32x2*)(PP + off); const f32x4 a = acc[ai][bj][m][n];
                        f32x4 o; o[0] = lo16(hv.x) + sigmoidf_(a[0] * r3) * lo16(pv.x); o[1] = hi16(hv.x) + sigmoidf_(a[1] * r3) * hi16(pv.x);
                        o[2] = lo16(hv.y) + sigmoidf_(a[2] * r3) * lo16(pv.y); o[3] = hi16(hv.y) + sigmoidf_(a[3] * r3) * hi16(pv.y);
                        ss += (o[0] * o[0] + o[1] * o[1]) + (o[2] * o[2] + o[3] * o[3]);
                        *(f32x4*)(out + off) = o; }
                ss += __shfl_xor(ss, 16); ss += __shfl_xor(ss, 32); if (fq == 0) FSS[row * 16 + u.pn * 4 + wc] = ss; }
    }
};

struct S5Order {
    const char* SH; const char* BT; int npn, nrowsB, ldb, G, c;
    __device__ bool next(int i, Unit& u) const {
        const int L = i * G + c; if (L >= SG * npn * 2) return false;
        const int g = L / (npn * 2), rem = L % (npn * 2); u.pn = rem >> 1; u.pm = rem & 1; u.aux = g;
        u.A = SH + (size_t)(g * NCHK + u.pm * 256) * KS5 * 2; u.B = BT + (size_t)(g * nrowsB + u.pn * 256) * ldb * 2; return true;
    }
};
struct OneUnit { Unit u; __device__ bool next(int i, Unit& o) const { if (i) return false; o = u; return true; } };
struct MoeOrder {
    const char* Abase; size_t tA; const char* Bbase; size_t eB, tB; const LAS int* tb; int npn, G, c;
    __device__ bool next(int i, Unit& u) const {
        const int L = i * G + c; const int ntile = __builtin_amdgcn_readfirstlane(tb[NE]);
        if (L >= ntile * npn) return false;
        const int tile = L / npn; u.pn = L % npn; u.pm = tile; int e = 0;
        for (int j = 1; j < NE; ++j) e += (__builtin_amdgcn_readfirstlane(tb[j]) <= tile) ? 1 : 0;
        u.aux = e; u.A = Abase + (size_t)tile * tA; u.B = Bbase + (size_t)e * eB + (size_t)u.pn * tB; return true;
    }
};

__device__ __forceinline__ void gmlp_unit(const Args& args, Frame& F, int c, int h) {
    LAS bf16_t* vnT = (LAS bf16_t*)F.lds;
    LAS float* rv = (LAS float*)(F.lds + 64 * 136 * 2);
    const bf16_t* VG = DOP(bf16_t, DO_VG); const bf16_t* UG = DOP(bf16_t, DO_UG); const float* VSS = WSP(float, ST_VSS);
    const bf16_t* WM = WSP(bf16_t, WS_WM); bf16_t* MIX = WSP(bf16_t, WS_MIX); float* OASS = WSP(float, ST_OASS);
    const float* sgu = args.in[4]; const float* bsp = args.in[6];
    const int tid = F.tid, row0 = c * GCH;
    if (tid < 128) { const f32x4* p = (const f32x4*)(VSS + (size_t)(row0 + tid) * 8); const f32x4 a = p[0], b = p[1];
        rv[tid] = rsqrtf(((a[0] + a[1]) + (a[2] + a[3]) + (b[0] + b[1]) + (b[2] + b[3])) * (1.f / WA) + EPS); }
    __syncthreads();
    {
        const int s = tid >> 2, dq = (tid & 3) * 16; const float r = rv[s];
        const u32x4 a = *(const u32x4*)(VG + (size_t)(row0 + s) * WA + h * DH + dq), b = *(const u32x4*)(VG + (size_t)(row0 + s) * WA + h * DH + dq + 8);
        const unsigned w[8] = {a.x, a.y, a.z, a.w, b.x, b.y, b.z, b.w};
#pragma unroll
        for (int j = 0; j < 8; ++j) { const int d = dq + 2 * j; const float g0 = sgu[h * DH + d], g1 = sgu[h * DH + d + 1];
            vnT[d * 136 + s] = (bf16_t)f2bf(lo16(w[j]) * r * g0); vnT[(d + 1) * 136 + s] = (bf16_t)f2bf(hi16(w[j]) * r * g1); }
    }
    __syncthreads();
    const int wv = F.wave, lane = F.lane, dtile = wv & 1, ttile = wv >> 1, r = lane & 31, hh = lane >> 5;
    f32x16 acc;
#pragma unroll
    for (int i = 0; i < 16; ++i) acc[i] = 0.f;
    const int nks = 2 * (ttile + 1);
    const bf16_t* wrow = WM + ((size_t)(h * GCH + ttile * 32 + r) * GCH + 8 * hh);
    const LAS bf16_t* arow = vnT + (dtile * 32 + r) * 136 + 8 * hh;
    for (int ks = 0; ks < nks; ++ks) {
        const bf16x8 a = *(const LAS bf16x8*)(arow + ks * 16);
        const bf16x8 b = *(const bf16x8*)(wrow + ks * 16);
        acc = __builtin_amdgcn_mfma_f32_32x32x16_bf16(a, b, acc, 0, 0, 0);
    }
    const int t = ttile * 32 + r, row = row0 + t; const float bias = bsp[h * GCH + t]; float ss = 0.f;
#pragma unroll
    for (int gq = 0; gq < 4; ++gq) {
        const int d0 = dtile * 32 + 8 * gq + 4 * hh; const size_t uoff = (size_t)row * WA + h * DH + d0;
        const u32x2 uv = *(const u32x2*)(UG + uoff);
        const float o0 = lo16(uv.x) * (acc[4 * gq + 0] + bias), o1 = hi16(uv.x) * (acc[4 * gq + 1] + bias), o2 = lo16(uv.y) * (acc[4 * gq + 2] + bias), o3 = hi16(uv.y) * (acc[4 * gq + 3] + bias);
        ss += (o0 * o0 + o1 * o1) + (o2 * o2 + o3 * o3);
        u32x2 w; w.x = pk2(o0, o1); w.y = pk2(o2, o3);
        *(u32x2*)(MIX + (size_t)row * D + h * DH + d0) = w;
    }
    ss += __shfl_xor(ss, 32);
    if (hh == 0) OASS[row * 16 + h * 2 + dtile] = ss;
    __syncthreads();
}

__device__ __forceinline__ void s5_scan(Frame& F) {
    const int idx = F.bid * NTHR + F.tid; if (idx >= 4 * SG * SP) return;
    const int p = idx & 63, g = (idx >> 6) & 31, b = idx >> 11;
    const float* AL = WSP(float, ST_AL); const float ar = AL[(g * SP + p) * 2], ai = AL[(g * SP + p) * 2 + 1];
    const float* E = DOP(float, DO_E) + ((size_t)g * NCHK + b * CPB) * 128;
    bf16_t* SH = DOP(bf16_t, DO_SH) + ((size_t)g * NCHK + b * CPB) * KS5 + 512;
    float hr = 0.f, hi = 0.f;
    for (int j0 = 0; j0 < CPB; j0 += 8) {
        float er[8], ei[8];
#pragma unroll
        for (int j = 0; j < 8; ++j) { er[j] = E[(size_t)(j0 + j) * 128 + p]; ei[j] = E[(size_t)(j0 + j) * 128 + 64 + p]; }
#pragma unroll
        for (int j = 0; j < 8; ++j) {
            SH[(size_t)(j0 + j) * KS5 + p] = (bf16_t)f2bf(hr); SH[(size_t)(j0 + j) * KS5 + 64 + p] = (bf16_t)f2bf(hi);
            const float nr = ar * hr - ai * hi + er[j]; hi = ar * hi + ai * hr + ei[j]; hr = nr;
        }
    }
}

__device__ __forceinline__ void router_phase(const Args& args, Frame& F, unsigned* CNT) {
    constexpr int WRS = 1032;
    LAS bf16_t* WrL = (LAS bf16_t*)F.lds;
    LAS float* LG = (LAS float*)(F.lds + 48 * WRS * 2);
    LAS int* hist = (LAS int*)(F.lds + 48 * WRS * 2 + 2 * 64 * 48 * 4);
    const bf16_t* WR = WSP(bf16_t, WS_WR); const bf16_t* HB = DOP(bf16_t, DO_HB); const float* HSS = WSP(float, ST_HSS);
    const float* bc = args.in[22]; const float* bfine = args.in[24];
    float* R2 = WSP(float, ST_R2); int* RE = WSP(int, ST_RE); float* RW = WSP(float, ST_RW); int* RP = WSP(int, ST_SLOT); int* TOK = WSP(int, ST_TOK);
    const int tid = F.tid, lane = F.lane, wv = F.wave;
    for (int i = tid; i < 48 * 128; i += NTHR) { const int rr = i >> 7, ch = i & 127; *(LAS u32x4*)(WrL + rr * WRS + ch * 8) = *(const u32x4*)(WR + (size_t)rr * D + ch * 8); }
    __syncthreads();
    const int mt = wv & 3, kh = wv >> 2, fr = lane & 15, fq = lane >> 4;
    for (int unit = F.bid; unit < M / 64; unit += F.G) {
        const int row0 = unit * 64;
        if (tid < 64) hist[tid] = 0;
        f32x4 acc[3];
#pragma unroll
        for (int n = 0; n < 3; ++n) acc[n] = (f32x4){0.f, 0.f, 0.f, 0.f};
        const bf16_t* arow = HB + (size_t)(row0 + mt * 16 + fr) * D + kh * 512 + fq * 8;
#pragma unroll 4
        for (int ks = 0; ks < 16; ++ks) {
            const bf16x8 a = *(const bf16x8*)(arow + ks * 32);
#pragma unroll
            for (int n = 0; n < 3; ++n) { const bf16x8 b = *(const LAS bf16x8*)(WrL + (n * 16 + fr) * WRS + kh * 512 + ks * 32 + fq * 8);
                acc[n] = __builtin_amdgcn_mfma_f32_16x16x32_bf16(a, b, acc[n], 0, 0, 0); }
        }
#pragma unroll
        for (int n = 0; n < 3; ++n)
#pragma unroll
            for (int j = 0; j < 4; ++j) LG[(kh * 64 + mt * 16 + fq * 4 + j) * 48 + n * 16 + fr] = acc[n][j];
        __syncthreads();
        int e1 = 0, e2 = 0, l1 = 0, l2 = 0; float w1 = 0.f, w2 = 0.f, r2 = 0.f; const int row = row0 + tid;
        if (tid < 64) {
            const f32x4* hp = (const f32x4*)(HSS + (size_t)row * 16); const f32x4 s0 = hp[0], s1 = hp[1], s2 = hp[2], s3 = hp[3];
            const float ssum = ((s0[0] + s0[1]) + (s0[2] + s0[3])) + ((s1[0] + s1[1]) + (s1[2] + s1[3])) + ((s2[0] + s2[1]) + (s2[2] + s2[3])) + ((s3[0] + s3[1]) + (s3[2] + s3[3]));
            r2 = rsqrtf(ssum * (1.f / D) + EPS);
            const LAS float* lg0 = LG + tid * 48; const LAS float* lg1 = LG + (64 + tid) * 48;
            float lc[4]; int gs = 0; float lmax;
#pragma unroll
            for (int j = 0; j < 4; ++j) lc[j] = (lg0[j] + lg1[j]) * r2 + bc[j];
            lmax = lc[0];
#pragma unroll
            for (int j = 1; j < 4; ++j) if (lc[j] > lmax) { lmax = lc[j]; gs = j; }
            float den = 0.f;
#pragma unroll
            for (int j = 0; j < 4; ++j) den += __expf(lc[j] - lmax);
            const float pg = 1.0f / den;
            float lf[8];
#pragma unroll
            for (int j = 0; j < 8; ++j) lf[j] = (lg0[4 + gs * 8 + j] + lg1[4 + gs * 8 + j]) * r2 + bfine[gs * 8 + j];
            int i1 = 0; float m1 = lf[0];
#pragma unroll
            for (int j = 1; j < 8; ++j) if (lf[j] > m1) { m1 = lf[j]; i1 = j; }
            int i2 = -1; float m2 = -3.0e38f;
#pragma unroll
            for (int j = 0; j < 8; ++j) if (j != i1 && lf[j] > m2) { m2 = lf[j]; i2 = j; }
            const float q2 = __expf(m2 - m1); const float inv = pg / (1.0f + q2);
            w1 = inv; w2 = q2 * inv; e1 = gs * 8 + i1; e2 = gs * 8 + i2;
            l1 = atomicAdd((int*)&hist[e1], 1); l2 = atomicAdd((int*)&hist[e2], 1);
        }
        __syncthreads();
        if (tid < 32) hist[32 + tid] = (int)atomicAdd(&CNT[tid], (unsigned)hist[tid]);
        __syncthreads();
        if (tid < 64) {
            const int p1 = hist[32 + e1] + l1, p2 = hist[32 + e2] + l2;
            TOK[(size_t)e1 * M + p1] = row; TOK[(size_t)e2 * M + p2] = row;
            RE[row * 2] = e1; RE[row * 2 + 1] = e2; RP[row * 2] = p1; RP[row * 2 + 1] = p2; RW[row * 2] = w1; RW[row * 2 + 1] = w2; R2[row] = r2;
        }
        __syncthreads();
    }
}

__device__ __forceinline__ void moe_tiles(Frame& F, const unsigned* CNT) {
    LAS int* tb = (LAS int*)(F.lds + AUX_TB);
    if (F.tid == 0) { int t = 0; for (int e = 0; e < NE; ++e) { tb[e] = t; t += ((int)__hip_atomic_load(CNT + e, __ATOMIC_RELAXED, __HIP_MEMORY_SCOPE_AGENT) + 255) >> 8; } tb[NE] = t; }
    __syncthreads();
}

__device__ __forceinline__ void gather_phase(Frame& F, const unsigned* CNT) {
    const LAS int* tb = (const LAS int*)(F.lds + AUX_TB);
    const bf16_t* HB = DOP(bf16_t, DO_HB); bf16_t* XS = WSP(bf16_t, WS_XS);
    const int* TOK = WSP(int, ST_TOK); const int* RE = WSP(int, ST_RE); const float* RW = WSP(float, ST_RW); const float* R2 = WSP(float, ST_R2);
    float* SW = WSP(float, ST_SW); float* SR2 = WSP(float, ST_SR2);
    const int gw = F.bid * NWAVES + F.wave, NGW = F.G * NWAVES; const int nrows = tb[NE] * 256;
    for (int sr = gw; sr < nrows; sr += NGW) {
        const int tile = sr >> 8; int e = 0;
        for (int j = 1; j < NE; ++j) e += (tb[j] <= tile) ? 1 : 0;
        const int pos = sr - tb[e] * 256; const int ne = (int)CNT[e];
        u32x4 v0 = (u32x4){0u, 0u, 0u, 0u}, v1 = v0;
        if (pos < ne) {
            const int tok = TOK[(size_t)e * M + pos];
            const u32x4* src = (const u32x4*)(HB + (size_t)tok * D); v0 = src[F.lane]; v1 = src[64 + F.lane];
            if (F.lane == 0) { const int k = (RE[tok * 2] == e) ? 0 : 1; SW[sr] = RW[tok * 2 + k]; SR2[sr] = R2[tok]; }
        } else if (F.lane == 0) { SW[sr] = 0.f; SR2[sr] = 0.f; }
        u32x4* dst = (u32x4*)(XS + (size_t)sr * D); dst[F.lane] = v0; dst[64 + F.lane] = v1;
    }
}

constexpr int NPHASE = 13;
__global__ void __launch_bounds__(NTHR, 2) mk_fwd(Args args) {
    extern __shared__ __attribute__((aligned(16))) unsigned char lds_raw[];
    Frame F;
    F.lds = (LAS unsigned char*)lds_raw; F.tid = threadIdx.x; F.lane = F.tid & 63; F.wave = __builtin_amdgcn_readfirstlane(F.tid >> 6);
    F.G = gridDim.x; F.bid = blockIdx.x;
    F.ws = args.ws; F.dout = (unsigned char*)args.out;
    unsigned* ctl = (unsigned*)(F.ws + WS_CTL);
    unsigned* CNT = ctl + CW_CNT;
    for (int u = F.tid; u < (LDS_BYTES - AUX_OFF) / 4; u += NTHR) ((LAS unsigned*)(F.lds + AUX_OFF))[u] = 0u;
    __syncthreads();
    XcdBarrier bar; bar.bar = ctl + CW_BAR; bar.x = 0; bar.st = nullptr;
#if !MK_PER_PHASE
    bar = xcd_barrier_post(ctl + CW_BAR, (volatile LAS unsigned*)(F.lds + AUX_MISC) + 8);
#endif
    const int lo = args.ph_lo, hi = args.ph_hi;
#ifndef PHMASK
#define PHMASK 0xFFFF
#endif
#define IN(k) ((((PHMASK) >> (k)) & 1) && lo <= (k) && (k) < hi)
#if MK_PER_PHASE
#define SEAM(k) do { } while (0)
#else
#define SEAM(k) do { if (IN(k) && IN((k) + 1)) xcd_barrier(bar); } while (0)
#endif
    LAS unsigned char* ring = F.lds;
    const int c = F.bid;

    if (IN(0)) { p0_prologue(args, F); }
    SEAM(0);
    if (IN(1)) {
        pg8::DenseOrder S; S.init(WSP(bf16_t, WS_A0), D, WSP(bf16_t, WS_WIN), D, M, NPROJ, F.G, c);
        EpiProj E{DOP(bf16_t, DO_UG), DOP(bf16_t, DO_VG), DOP(bf16_t, DO_SH), WSP(float, ST_VSS)};
        pg8::gemm_phase<EpiProj, pg8::DenseOrder, true, false>(ring, pg8::Gemm{D, D, 16}, S, E);
    }
    SEAM(1);
    if (IN(2)) {
        for (int u = F.bid; u < (M / GCH) * HEADS; u += F.G) gmlp_unit(args, F, u >> 3, u & 7);
        S5Order S{(const char*)DOP(bf16_t, DO_SH), (const char*)WSP(bf16_t, WS_BT1), 1, 256, 512, F.G, c};
        EpiS5a E{DOP(float, DO_E)};
        pg8::gemm_phase<EpiS5a, S5Order, true, false>(ring, pg8::Gemm{KS5, 512, 8}, S, E);
    }
    SEAM(2);
    if (IN(3)) {
        s5_scan(F);
        pg8::DenseOrder S; S.init(WSP(bf16_t, WS_PB), PLE, WSP(bf16_t, WS_WPP), PLE, M, D, F.G, c);
        EpiBf E{WSP(bf16_t, WS_PP), D};
        pg8::gemm_phase<EpiBf, pg8::DenseOrder, true, false>(ring, pg8::Gemm{PLE, PLE, 4}, S, E);
    }
    SEAM(3);
    if (IN(4)) {
        S5Order S{(const char*)DOP(bf16_t, DO_SH), (const char*)WSP(bf16_t, WS_BT2), 2, 512, KS5, F.G, c};
        EpiS5b E{DOP(bf16_t, DO_SH), args.in[14], WSP(bf16_t, WS_Y2)};
        pg8::gemm_phase<EpiS5b, S5Order, true, false>(ring, pg8::Gemm{KS5, KS5, 10}, S, E);
    }
    SEAM(4);
    if (IN(5)) {
        pg8::DenseOrder S; S.init(WSP(bf16_t, WS_Y2), WB, WSP(bf16_t, WS_WGLU), WB, M, 2 * WB, F.G, c);
        EpiGlu E{args.in[16], WSP(bf16_t, WS_MIX), WSP(float, ST_OBSS)};
        pg8::gemm_phase<EpiGlu, pg8::DenseOrder, true, false>(ring, pg8::Gemm{WB, WB, 8}, S, E);
    }
    SEAM(5);
    if (IN(6)) {
        pg8::DenseOrder S; S.init(WSP(bf16_t, WS_MIX), D, WSP(bf16_t, WS_WOUT), D, M, D, F.G, c);
        LAS float* ra = (LAS float*)(F.lds + AUX_RA); LAS float* rb = (LAS float*)(F.lds + AUX_RB);
        EpiOut E{args.in[0], DOP(bf16_t, DO_HB), WSP(float, ST_HSS), ra, rb};
        for (int i = 0;; ++i) {
            Unit u; if (!S.next(i, u)) break;
            __syncthreads();
            if (F.tid < 256) { const int row = u.pm * 256 + F.tid; const f32x4* pa = (const f32x4*)(WSP(float, ST_OASS) + (size_t)row * 16); const f32x4* pb = (const f32x4*)(WSP(float, ST_OBSS) + (size_t)row * 16);
                float sa = 0.f, sb = 0.f;
#pragma unroll
                for (int j = 0; j < 4; ++j) { const f32x4 a = pa[j], b = pb[j]; sa += (a[0] + a[1]) + (a[2] + a[3]); sb += (b[0] + b[1]) + (b[2] + b[3]); }
                ra[F.tid] = rsqrtf(sa * (1.f / WA) + EPS); rb[F.tid] = rsqrtf(sb * (1.f / WB) + EPS); }
            __syncthreads();
            OneUnit O{u};
            pg8::gemm_phase<EpiOut, OneUnit, false, true>(ring, pg8::Gemm{D, D, 16}, O, E);
        }
    }
    SEAM(6);
    if (IN(7)) { router_phase(args, F, CNT); }
    SEAM(7);
    if (IN(8)) { moe_tiles(F, CNT); gather_phase(F, CNT); }
    SEAM(8);
    if (IN(9)) {
        moe_tiles(F, CNT);
        MoeOrder S{(const char*)WSP(bf16_t, WS_XS), (size_t)256 * D * 2, (const char*)WSP(bf16_t, WS_WGU), (size_t)512 * D * 2, (size_t)256 * D * 2, (const LAS int*)(F.lds + AUX_TB), 2, F.G, c};
        EpiGU E{WSP(float, ST_SR2), DOP(bf16_t, DO_HH)};
        pg8::gemm_phase<EpiGU, MoeOrder, true, false>(ring, pg8::Gemm{D, D, 16}, S, E);
    }
    SEAM(9);
    if (IN(10)) {
        moe_tiles(F, CNT);
        MoeOrder S{(const char*)DOP(bf16_t, DO_HH), (size_t)256 * FE * 2, (const char*)WSP(bf16_t, WS_WD), (size_t)D * FE * 2, (size_t)256 * FE * 2, (const LAS int*)(F.lds + AUX_TB), 4, F.G, c};
        EpiDown E{WSP(float, ST_SW), WSP(bf16_t, WS_XS)};
        pg8::gemm_phase<EpiDown, MoeOrder, true, false>(ring, pg8::Gemm{FE, FE, 4}, S, E);
    }
    SEAM(10);
    if (IN(11)) {
        moe_tiles(F, CNT);
        const LAS int* tb = (const LAS int*)(F.lds + AUX_TB);
        const bf16_t* HB = DOP(bf16_t, DO_HB); const bf16_t* YE = WSP(bf16_t, WS_XS); bf16_t* H2B = WSP(bf16_t, WS_A0);
        const int* RE = WSP(int, ST_RE); const int* RP = WSP(int, ST_SLOT); float* R3 = WSP(float, ST_R3);
        const int gw = F.bid * NWAVES + F.wave, NGW = F.G * NWAVES;
        for (int m = gw; m < M; m += NGW) {
            const int e1 = RE[m * 2], e2 = RE[m * 2 + 1]; const int s1 = tb[e1] * 256 + RP[m * 2], s2 = tb[e2] * 256 + RP[m * 2 + 1];
            const u32x4* ph = (const u32x4*)(HB + (size_t)m * D); const u32x4* p1 = (const u32x4*)(YE + (size_t)s1 * D); const u32x4* p2 = (const u32x4*)(YE + (size_t)s2 * D);
            float ss = 0.f;
#pragma unroll
            for (int j = 0; j < 2; ++j) {
                const u32x4 a = ph[F.lane + 64 * j], b = p1[F.lane + 64 * j], cc = p2[F.lane + 64 * j];
                const unsigned aw[4] = {a.x, a.y, a.z, a.w}, bw[4] = {b.x, b.y, b.z, b.w}, cw[4] = {cc.x, cc.y, cc.z, cc.w}; unsigned ow[4];
#pragma unroll
                for (int q = 0; q < 4; ++q) { const float lo = lo16(aw[q]) + lo16(bw[q]) + lo16(cw[q]), hi_ = hi16(aw[q]) + hi16(bw[q]) + hi16(cw[q]); ss += lo * lo + hi_ * hi_; ow[q] = pk2(lo, hi_); }
                ((u32x4*)(H2B + (size_t)m * D))[F.lane + 64 * j] = (u32x4){ow[0], ow[1], ow[2], ow[3]};
            }
            ss = wave_sum(ss);
            if (F.lane == 0) R3[m] = rsqrtf(ss * (1.f / D) + EPS);
        }
    }
    SEAM(11);
    if (IN(12)) {
        pg8::DenseOrder S; S.init(WSP(bf16_t, WS_A0), D, WSP(bf16_t, WS_WPG), D, M, D, F.G, c);
        EpiPle E{WSP(bf16_t, WS_A0), WSP(bf16_t, WS_PP), WSP(float, ST_R3), args.out, WSP(float, ST_FSS)};
        pg8::gemm_phase<EpiPle, pg8::DenseOrder, true, false>(ring, pg8::Gemm{D, D, 16}, S, E);
    }
    SEAM(12);
    if (IN(13)) {
        const float* FSS = WSP(float, ST_FSS); const float* gf = args.in[31]; float* out = args.out;
        const int gw = F.bid * NWAVES + F.wave, NGW = F.G * NWAVES;
        f32x4 gv[4];
#pragma unroll
        for (int j = 0; j < 4; ++j) gv[j] = ((const f32x4*)gf)[F.lane + 64 * j];
        for (int m = gw; m < M; m += NGW) {
            const float sv = (F.lane < 16) ? FSS[(size_t)m * 16 + F.lane] : 0.f; const float r = rsqrtf(wave_sum(sv) * (1.f / D) + EPS);
            f32x4* o = (f32x4*)(out + (size_t)m * D) + F.lane;
#pragma unroll
            for (int j = 0; j < 4; ++j) { f32x4 v = o[64 * j]; v = v * r * gv[j]; o[64 * j] = v; }
        }
    }
#undef IN
#undef SEAM
}

extern "C" void kernel_launch(void* const* d_in, const int* in_sizes, int n_in, void* d_out, int out_size, void* d_ws, size_t ws_size, hipStream_t stream) {
    static int grid = 0;
    if (grid == 0) {
        if (n_in != 32 || in_sizes[0] != M * D || out_size != M * D || ws_size < WS_END) { fprintf(stderr, "kernel_launch: unexpected shapes (n_in %d, in0 %d, out %d, ws %zu, need %zu)\n", n_in, n_in > 0 ? in_sizes[0] : -1, out_size, ws_size, (size_t)WS_END); grid = -1; return; }
        int dev = 0, cus = 0, per_cu = 0;
        if (hipGetDevice(&dev) != hipSuccess || hipDeviceGetAttribute(&cus, hipDeviceAttributeMultiprocessorCount, dev) != hipSuccess) { grid = -1; return; }
        if (hipFuncSetAttribute((const void*)mk_fwd, hipFuncAttributeMaxDynamicSharedMemorySize, LDS_BYTES) != hipSuccess) { fprintf(stderr, "kernel_launch: hipFuncSetAttribute failed\n"); grid = -1; return; }
        if (hipOccupancyMaxActiveBlocksPerMultiprocessor(&per_cu, (const void*)mk_fwd, NTHR, LDS_BYTES) != hipSuccess || per_cu < 1) { fprintf(stderr, "kernel_launch: occupancy query says %d\n", per_cu); (void)hipGetLastError(); per_cu = 1; }
        grid = cus;
    }
    if (grid < 0) return;
    (void)hipMemsetAsync((char*)d_ws + WS_CTL, 0, CTL_ZERO, stream);
    Args a{};
    for (int i = 0; i < 32; ++i) a.in[i] = (const float*)d_in[i];
    a.out = (float*)d_out; a.ws = (unsigned char*)d_ws;
#if MK_PER_PHASE
    for (int ph = 0; ph <= NPHASE; ++ph) { a.ph_lo = ph; a.ph_hi = ph + 1; hipLaunchKernelGGL(mk_fwd, dim3(grid), dim3(NTHR), LDS_BYTES, stream, a); }
#else
    a.ph_lo = 0; a.ph_hi = NPHASE + 1;
    hipLaunchKernelGGL(mk_fwd, dim3(grid), dim3(NTHR), LDS_BYTES, stream, a);
#endif
}
```

```cpp
#include <hip/hip_runtime.h>
#include <cstdio>
#include <cstdint>

#ifndef MK_PER_PHASE
#define MK_PER_PHASE 0
#endif

#define PHREP (-1)
#define SUBREP (0)

#define LAS __attribute__((address_space(3)))
#define GAS __attribute__((address_space(1)))
typedef unsigned short bf16_t;
typedef short bf16x8 __attribute__((ext_vector_type(8)));
typedef float f32x4 __attribute__((ext_vector_type(4)));
typedef float f32x16 __attribute__((ext_vector_type(16)));
typedef unsigned u32x4 __attribute__((ext_vector_type(4)));
typedef unsigned u32x2 __attribute__((ext_vector_type(2)));

constexpr int M = 16384, D = 1024, WA = 512, WB = 512, NPROJ = 1536;
constexpr int SEQ = 4096;
constexpr int GCH = 128, HEADS = 8, DH = 64;
constexpr int SG = 32, SC = 16, SP = 64;
constexpr int SL = 32;
constexpr int NCHK = M / SL;
constexpr int CPB = SEQ / SL;
constexpr int KS5 = SL * SC + 2 * SP;
constexpr int NE = 32, FE = 256, EPG = 8, NGRP = 4;
constexpr int PLE = 256;
constexpr int SROWS = 2 * M + NE * 256;
constexpr float EPS = 1e-6f;

constexpr size_t MiB = 1u << 20;
constexpr size_t WS_CTL   = 0;
constexpr size_t CTL_ZERO = 65536;
constexpr size_t WS_STAT  = 1 * MiB;
constexpr size_t ST_VSS = WS_STAT;
constexpr size_t ST_OASS = ST_VSS + (size_t)M * 8 * 4;
constexpr size_t ST_OBSS = ST_OASS + (size_t)M * 16 * 4;
constexpr size_t ST_HSS = ST_OBSS + (size_t)M * 16 * 4;
constexpr size_t ST_FSS = ST_HSS + (size_t)M * 16 * 4;
constexpr size_t ST_R2 = ST_FSS + (size_t)M * 16 * 4;
constexpr size_t ST_R3 = ST_R2 + (size_t)M * 4;
constexpr size_t ST_RE = ST_R3 + (size_t)M * 4;
constexpr size_t ST_RW = ST_RE + (size_t)M * 8;
constexpr size_t ST_SLOT = ST_RW + (size_t)M * 8;
constexpr size_t ST_TOK = ST_SLOT + (size_t)M * 8;
constexpr size_t ST_SW = ST_TOK + (size_t)NE * M * 4;
constexpr size_t ST_SR2 = ST_SW + (size_t)SROWS * 4;
constexpr size_t ST_AL = ST_SR2 + (size_t)SROWS * 4;
constexpr size_t ST_END = ST_AL + (size_t)SG * SP * 8;
static_assert(ST_END <= 12 * MiB, "stats region");
constexpr size_t WS_WGU  = 12 * MiB;
constexpr size_t WS_WD   = WS_WGU + 32 * MiB;
constexpr size_t WS_WPG  = WS_WD + 16 * MiB;
constexpr size_t WS_WPP  = WS_WPG + 2 * MiB;
constexpr size_t WS_WIN  = WS_WPP + 1 * MiB;
constexpr size_t WS_WGLU = WS_WIN + 3 * MiB;
constexpr size_t WS_WOUT = WS_WGLU + 1 * MiB;
constexpr size_t WS_WM   = WS_WOUT + 2 * MiB;
constexpr size_t WS_WR   = WS_WM + 256 * 1024;
constexpr size_t WS_A0   = WS_WM + 1 * MiB;
constexpr size_t WS_PP   = WS_A0 + 32 * MiB;
constexpr size_t WS_LATE = WS_PP + 32 * MiB;
constexpr size_t WS_BT1  = WS_LATE;
constexpr size_t WS_BT2  = WS_BT1 + 8 * MiB;
constexpr size_t WS_MIX  = WS_BT2 + 20 * MiB;
constexpr size_t WS_Y2   = WS_MIX + 32 * MiB;
constexpr size_t WS_PB   = WS_Y2 + 16 * MiB;
constexpr size_t WS_XS   = WS_LATE;
constexpr size_t WS_END  = WS_LATE + 84 * MiB;
static_assert(WS_END <= 256 * MiB, "workspace");
constexpr size_t DO_UG = 0;
constexpr size_t DO_VG = 16 * MiB;
constexpr size_t DO_SH = 32 * MiB;
constexpr size_t DO_E  = 52 * MiB;
constexpr size_t DO_HB = 0;
constexpr size_t DO_HH = 32 * MiB;
constexpr int CW_BAR = 0;
constexpr int CW_CNT = 4096;

__device__ __forceinline__ float bf2f(unsigned v) { return __uint_as_float(v << 16); }
__device__ __forceinline__ unsigned f2bf(float f) { unsigned u = __float_as_uint(f); return (u + 0x7fffu + ((u >> 16) & 1u)) >> 16; }
__device__ __forceinline__ unsigned pk2(float lo, float hi) { unsigned r; asm volatile("v_cvt_pk_bf16_f32 %0, %1, %2" : "=v"(r) : "v"(lo), "v"(hi)); return r; }
__device__ __forceinline__ float lo16(unsigned w) { return __uint_as_float(w << 16); }
__device__ __forceinline__ float hi16(unsigned w) { return __uint_as_float(w & 0xffff0000u); }
__device__ __forceinline__ float sigmoidf_(float x) { return __builtin_amdgcn_rcpf(1.0f + __expf(-x)); }
__device__ __forceinline__ float gelu_t(float x) { const float u = x * (1.0f + 0.044715f * x * x); return x * __builtin_amdgcn_rcpf(1.0f + __expf(-1.5957691216057308f * u)); }
__device__ __forceinline__ float wave_sum(float v) {
#pragma unroll
    for (int o = 1; o < 64; o <<= 1) v += __shfl_xor(v, o);
    return v;
}
#define LDS_WAIT() asm volatile("s_waitcnt lgkmcnt(0)" ::: "memory")
#define VM_WAIT() asm volatile("s_waitcnt vmcnt(0)" ::: "memory")

namespace pg8 {
constexpr int BM = 256, BK = 64, HALF = 128, HTB = HALF * BK * 2, STAGE_BYTES = 8 * HTB, NXCD = 8, WGM = 8;
__host__ __device__ __forceinline__ int lds_byte(int r, int c) { const int st = (r >> 4) * 2 + (c >> 5), rr = r & 15, cc = c & 31, ob = rr * 64 + cc * 2; return st * 1024 + (ob ^ (((ob >> 9) & 1) << 5)); }
__host__ __device__ __forceinline__ void stage_rc(int b, int& R, int& C) { const int st = b / 1024, sb = b % 1024, swz = sb ^ (((sb >> 9) & 1) << 5); R = (st >> 1) * 16 + swz / 64; C = (st & 1) * 32 + (swz % 64) / 2; }
__host__ __device__ __forceinline__ int perm32(int rho) { const int n = rho >> 4, i = rho & 15; return 8 * (i >> 2) + 4 * n + (i & 3); }

struct Unit { const char* A; const char* B; int pm, pn, aux; };
struct Gemm { int lda, ldb, nt; };

struct DenseOrder {
    const char* A; const char* B; size_t tA, tB; int nM, nN, nwg, G, c;
    __device__ void init(const void* A_, int lda, const void* B_, int ldb, int Mr, int Nc, int G_, int c_) { A = (const char*)A_; B = (const char*)B_; tA = (size_t)BM * lda * 2; tB = (size_t)BM * ldb * 2; nM = Mr / BM; nN = Nc / BM; nwg = nM * nN; G = G_; c = c_; }
    __device__ bool next(int i, Unit& u) const {
        const long L = (long)i * G + c; if (L >= nwg) return false;
        int wgid = (int)L; { const int q = nwg / NXCD, r = nwg % NXCD, xcd = wgid % NXCD, off = wgid / NXCD; wgid = (xcd < r ? xcd * (q + 1) : r * (q + 1) + (xcd - r) * q) + off; }
        const int nig = WGM * nN, gid = wgid / nig, fm = gid * WGM, gsz = (nM - fm) < WGM ? (nM - fm) : WGM;
        u.pm = fm + ((wgid % nig) % gsz); u.pn = (wgid % nig) / gsz; u.aux = 0;
        u.A = A + (size_t)u.pm * tA; u.B = B + (size_t)u.pn * tB; return true;
    }
};

template <class Epi, class Sched, bool ALIGN_EPI, bool HOOK>
__device__ __forceinline__ void gemm_phase(LAS unsigned char* lds, const Gemm g, const Sched& S, const Epi& E) {
    const int tid = threadIdx.x, wid = __builtin_amdgcn_readfirstlane(tid >> 6), lane = tid & 63, wr = wid >> 2, wc = wid & 3, fr = lane & 15, fq = lane >> 4;
    int nt_ = g.nt; asm volatile("" : "+s"(nt_)); const int nt = nt_;
    unsigned voffA[2], voffB[2];
#pragma unroll
    for (int i = 0; i < 2; ++i) { int R, C; stage_rc(tid * 16 + i * 8192, R, C); const int Rb = Epi::PERM ? ((R & ~31) + perm32(R & 31)) : R;
        voffA[i] = (unsigned)(R * g.lda + C) * 2u; voffB[i] = (unsigned)(Rb * g.ldb + C) * 2u; }
    const size_t kstep = (size_t)(BK * 2);
    const size_t hstepA = (size_t)HALF * g.lda * 2, hstepB = (size_t)HALF * g.ldb * 2;
    const unsigned ldsw = (unsigned)wid * 1024u;
    const int aoff = lds_byte(wr * 64 + fr, fq * 8), boff = lds_byte(wc * 32 + fr, fq * 8);
#define PG8_SA(b, h) (((b) * 2 + (h)) * HTB)
#define PG8_SB(b, h) ((4 + (b) * 2 + (h)) * HTB)
#define PG8_STAGE(bufoff, gbase, voff) do { _Pragma("unroll") for (int _i = 0; _i < 2; ++_i) \
        __builtin_amdgcn_global_load_lds((const unsigned*)((const char*)(gbase) + (voff)[_i]), (LAS unsigned*)(lds + (bufoff) + ldsw + _i * 8192), 16, 0, 0); } while (0)
#define PG8_LDA(dst, b, h) do { _Pragma("unroll") for (int m = 0; m < 4; ++m) _Pragma("unroll") for (int k = 0; k < 2; ++k) dst[m][k] = *(const LAS bf16x8*)(lds + PG8_SA(b, h) + aoff + m * 2048 + k * 1024); } while (0)
#define PG8_LDB(dst, b, h) do { _Pragma("unroll") for (int n = 0; n < 2; ++n) _Pragma("unroll") for (int k = 0; k < 2; ++k) dst[n][k] = *(const LAS bf16x8*)(lds + PG8_SB(b, h) + boff + n * 2048 + k * 1024); } while (0)
#define PG8_MMA(ai, bj, At, Bt) do { __builtin_amdgcn_s_setprio(1); _Pragma("unroll") for (int m = 0; m < 4; ++m) _Pragma("unroll") for (int n = 0; n < 2; ++n) _Pragma("unroll") for (int k = 0; k < 2; ++k) \
        acc[ai][bj][m][n] = __builtin_amdgcn_mfma_f32_16x16x32_bf16(Bt[n][k], At[m][k], acc[ai][bj][m][n], 0, 0, 0); __builtin_amdgcn_s_setprio(0); } while (0)
#define PG8_WAIT_V(n) asm volatile("s_waitcnt vmcnt(" #n ")" ::: "memory")
#define PG8_WAIT_L(n) asm volatile("s_waitcnt lgkmcnt(" #n ")" ::: "memory")
#define PG8_BAR __builtin_amdgcn_s_barrier()
#define PG8_SCHED __builtin_amdgcn_sched_barrier(0)
    Unit cur, nxt; int ui = 0;
    if (!S.next(0, cur)) return;
    f32x4 acc[2][2][4][2];
#pragma unroll
    for (int a = 0; a < 2; ++a)
#pragma unroll
        for (int b = 0; b < 2; ++b)
#pragma unroll
            for (int m = 0; m < 4; ++m)
#pragma unroll
                for (int n = 0; n < 2; ++n) acc[a][b][m][n] = (f32x4){0.f, 0.f, 0.f, 0.f};
    bf16x8 At[4][2], B0[2][2], B1[2][2];
    const char* cA = cur.A; const char* cB = cur.B;
    PG8_STAGE(PG8_SB(0, 0), cB, voffB); PG8_STAGE(PG8_SB(0, 1), cB + hstepB, voffB); PG8_STAGE(PG8_SA(0, 0), cA, voffA); PG8_STAGE(PG8_SA(0, 1), cA + hstepA, voffA);
    if (wr == 1) PG8_BAR;
    PG8_WAIT_V(2); PG8_BAR;
    PG8_STAGE(PG8_SB(1, 0), cB + kstep, voffB); PG8_STAGE(PG8_SA(1, 0), cA + kstep, voffA); PG8_STAGE(PG8_SB(1, 1), cB + hstepB + kstep, voffB);
    PG8_WAIT_V(6); PG8_BAR;
    for (;;) {
        const bool has_next = S.next(ui + 1, nxt);
        const char* nA = has_next ? nxt.A : cA; const char* nB = has_next ? nxt.B : cB;
        for (int t = 0; t < nt; t += 2) {
            const bool last = (t == nt - 2);
            if constexpr (HOOK) { if (t == E.hook_t) E.mid(acc, wr, fr); }
            const char* a1 = cA + (size_t)(t + 1) * kstep;
            const char* a2 = last ? nA : cA + (size_t)(t + 2) * kstep; const char* b2 = last ? nB : cB + (size_t)(t + 2) * kstep;
            const char* a3 = a2 + kstep; const char* b3 = b2 + kstep;
            PG8_LDB(B0, 0, 0); PG8_LDB(B1, 0, 1); PG8_SCHED; PG8_LDA(At, 0, 0); PG8_STAGE(PG8_SA(1, 1), a1 + hstepA, voffA);
            PG8_WAIT_V(8); PG8_WAIT_L(0); PG8_BAR; PG8_MMA(0, 0, At, B0); PG8_MMA(0, 1, At, B1); PG8_BAR; PG8_SCHED;
            PG8_LDA(At, 0, 1); PG8_STAGE(PG8_SB(0, 0), b2, voffB); PG8_STAGE(PG8_SB(0, 1), b2 + hstepB, voffB); PG8_STAGE(PG8_SA(0, 0), a2, voffA);
            PG8_WAIT_V(8); PG8_WAIT_L(0); PG8_BAR; PG8_MMA(1, 0, At, B0); PG8_MMA(1, 1, At, B1); PG8_BAR; PG8_SCHED;
            PG8_LDB(B0, 1, 0); PG8_LDB(B1, 1, 1); PG8_SCHED; PG8_LDA(At, 1, 0); PG8_STAGE(PG8_SA(0, 1), a2 + hstepA, voffA);
            PG8_WAIT_V(8); PG8_WAIT_L(0); PG8_BAR; PG8_MMA(0, 0, At, B0); PG8_MMA(0, 1, At, B1); PG8_BAR; PG8_SCHED;
            PG8_LDA(At, 1, 1); PG8_STAGE(PG8_SB(1, 0), b3, voffB); PG8_STAGE(PG8_SB(1, 1), b3 + hstepB, voffB); PG8_STAGE(PG8_SA(1, 0), a3, voffA);
            PG8_WAIT_V(8); PG8_WAIT_L(0); PG8_BAR; PG8_MMA(1, 0, At, B0); PG8_MMA(1, 1, At, B1); PG8_BAR; PG8_SCHED;
        }
        if constexpr (ALIGN_EPI) { if (wr == 0) PG8_BAR; }
        E(acc, cur, wr, wc, fr, fq);
        if (!has_next) break;
#pragma unroll
        for (int a = 0; a < 2; ++a)
#pragma unroll
            for (int b = 0; b < 2; ++b)
#pragma unroll
                for (int m = 0; m < 4; ++m)
#pragma unroll
                    for (int n = 0; n < 2; ++n) acc[a][b][m][n] = (f32x4){0.f, 0.f, 0.f, 0.f};
        cur = nxt; cA = nA; cB = nB; ++ui;
        if constexpr (ALIGN_EPI) { if (wr == 1) PG8_BAR; }
    }
    PG8_WAIT_V(0);
    if constexpr (!ALIGN_EPI) { if (wr == 0) PG8_BAR; }
    PG8_BAR;
#undef PG8_SA
#undef PG8_SB
#undef PG8_STAGE
#undef PG8_LDA
#undef PG8_LDB
#undef PG8_MMA
#undef PG8_WAIT_V
#undef PG8_WAIT_L
#undef PG8_BAR
#undef PG8_SCHED
}
}
using pg8::Unit;

#define XB_TMO      128
#define XB_XCNT(j)  (256  + 64 * (j))
#define XB_XSUB(j)  (1280 + 64 * (j))
#define XB_XGEN(j)  (2304 + 64 * (j))
#define XB_TOP      3328
#define XB_TOPGEN   3392
#define XCD_BAR_WORDS 3456
#define XB_SPIN_CAP (1u << 18)
__device__ __forceinline__ unsigned xb_ld(unsigned* p)              { return __hip_atomic_load(p, __ATOMIC_RELAXED, __HIP_MEMORY_SCOPE_AGENT); }
__device__ __forceinline__ unsigned xb_add(unsigned* p, unsigned v) { return __hip_atomic_fetch_add(p, v, __ATOMIC_RELAXED, __HIP_MEMORY_SCOPE_AGENT); }
__device__ __forceinline__ unsigned xb_xcc_id() { return (unsigned)__builtin_amdgcn_s_getreg((3 << 11) | 20) & 0xFu; }
#define XB_SPIN(cond, bar) do { unsigned _sp = 0; while (cond) { __builtin_amdgcn_s_sleep(1); \
    if ((++_sp & 255u) == 0u) { if (xb_ld(&(bar)[XB_TMO])) break; if (_sp > XB_SPIN_CAP) { atomicAdd(&(bar)[XB_TMO], 1u); break; } } } } while (0)
struct XcdBarrier { unsigned* bar; unsigned x; volatile LAS unsigned* st; };
__device__ __forceinline__ XcdBarrier xcd_barrier_post(unsigned* bar, volatile LAS unsigned* st) {
    XcdBarrier b; b.bar = bar; b.x = xb_xcc_id(); b.st = st;
    if (threadIdx.x == 0) (void)xb_add(&bar[XB_XCNT(b.x)], 1u);
    return b;
}
__device__ __forceinline__ void xcd_barrier_complete(unsigned* bar, unsigned x, unsigned& nloc, unsigned& nx) {
    const unsigned G = gridDim.x * gridDim.y * gridDim.z;
    unsigned sum, cnt, mine, sp = 0u;
    for (;;) {
        sum = 0u; cnt = 0u; mine = 0u;
#pragma unroll
        for (unsigned j = 0; j < 16; ++j) { const unsigned c = xb_ld(&bar[XB_XCNT(j)]); sum += c; cnt += (c > 0u) ? 1u : 0u; mine = (j == x) ? c : mine; }
        if (sum == G) break;
        __builtin_amdgcn_s_sleep(1);
        if ((++sp & 255u) == 0u) { if (xb_ld(&bar[XB_TMO])) break; if (sp > XB_SPIN_CAP) { atomicAdd(&bar[XB_TMO], 1u); break; } }
    }
    nloc = mine > 0u ? mine : 1u; nx = cnt > 0u ? cnt : 1u;
}
__device__ __forceinline__ void xcd_barrier(const XcdBarrier& b) {
    asm volatile("s_waitcnt vmcnt(0)" ::: "memory");
    __syncthreads();
    if (threadIdx.x == 0) {
        unsigned* bar = b.bar;
        __builtin_amdgcn_s_waitcnt(0);
        unsigned nloc = b.st[0], nx = b.st[1];
        if (nloc == 0u) { xcd_barrier_complete(bar, b.x, nloc, nx); b.st[0] = nloc; b.st[1] = nx; }
        const unsigned old = xb_add(&bar[XB_XSUB(b.x)], 1u);
        const unsigned gen = old / nloc;
        if (old + 1u == (gen + 1u) * nloc) {
            __builtin_amdgcn_fence(__ATOMIC_RELEASE, "agent");
            asm volatile("s_waitcnt vmcnt(0)" ::: "memory");
            const unsigned og = xb_add(&bar[XB_TOP], 1u);
            const unsigned tg = og / nx;
            if (og + 1u == (tg + 1u) * nx) xb_add(&bar[XB_TOPGEN], 1u);
            else XB_SPIN(xb_ld(&bar[XB_TOPGEN]) == tg, bar);
            __builtin_amdgcn_fence(__ATOMIC_ACQUIRE, "agent");
            xb_add(&bar[XB_XGEN(b.x)], 1u);
            asm volatile("s_waitcnt vmcnt(0)" ::: "memory");
        } else {
            XB_SPIN(xb_ld(&bar[XB_XGEN(b.x)]) == gen, bar);
            __builtin_amdgcn_fence(__ATOMIC_ACQUIRE, "agent");
            asm volatile("s_waitcnt vmcnt(0)" ::: "memory");
        }
    }
    __syncthreads();
}

constexpr int NWAVES = 8, NTHR = 512;
constexpr int RING_BYTES = 131072;
constexpr int AUX_OFF = RING_BYTES;
constexpr int AUX_MISC = AUX_OFF;
constexpr int AUX_RA = AUX_OFF + 256;
constexpr int AUX_RB = AUX_RA + 1024;
constexpr int AUX_TB = AUX_RB + 1024;
constexpr int LDS_BYTES = 147456;

struct Args { const float* in[32]; float* out; unsigned char* ws; int ph_lo, ph_hi; };

struct Frame {
    LAS unsigned char* lds;
    int tid, lane, wave, G, bid;
    unsigned char* ws; unsigned char* dout;
};
#define WSP(T, off) ((T*)(F.ws + (off)))
#define DOP(T, off) ((T*)(F.dout + (off)))

template <class PW, class PS>
__device__ __forceinline__ void transpose_item(PW W, int ldw, int k0, int n0, PS kscale, bool has_scale, bf16_t* WT, int ldt, int dst_row0, LAS unsigned* scr, int lane) {
    const int c4 = lane & 15, rq = lane >> 4;
    f32x4 v[8][2];
#pragma unroll
    for (int i = 0; i < 8; ++i)
#pragma unroll
        for (int h = 0; h < 2; ++h) v[i][h] = *(const f32x4*)(W + (size_t)(k0 + 8 * i + 2 * rq + h) * ldw + n0 + 4 * c4);
    if (has_scale) {
#pragma unroll
        for (int i = 0; i < 8; ++i)
#pragma unroll
            for (int h = 0; h < 2; ++h) v[i][h] = v[i][h] * kscale[k0 + 8 * i + 2 * rq + h];
    }
#pragma unroll
    for (int i = 0; i < 8; ++i)
#pragma unroll
        for (int j = 0; j < 4; ++j) scr[(4 * c4 + j) * 33 + 4 * i + rq] = pk2(v[i][0][j], v[i][1][j]);
    LDS_WAIT(); asm volatile("" ::: "memory");
    const int c = lane & 7;
#pragma unroll
    for (int jj = 0; jj < 8; ++jj) { const int n = (lane >> 3) + 8 * jj; const LAS unsigned* sp = scr + n * 33 + 4 * c;
        u32x4 o; o.x = sp[0]; o.y = sp[1]; o.z = sp[2]; o.w = sp[3];
        *(u32x4*)(WT + (size_t)(dst_row0 + n) * ldt + k0 + 8 * c) = o; }
    LDS_WAIT(); asm volatile("" ::: "memory");
}

template <class AT_> __device__ __forceinline__ void s5_precompute(const AT_& args, Frame& F, int g, int part) {
    LAS float* pwr = (LAS float*)F.lds;
    LAS float* pwi = pwr + 64 * 33;
    LAS float* bbr = pwi + 64 * 33;
    LAS float* bbi = bbr + 64 * 16;
    LAS float* ccr = bbi + 64 * 16;
    LAS float* cci = ccr + 64 * 16;
    LAS float* Kt = cci + 64 * 16;
    const float* a_re = args.in[7]; const float* a_im = args.in[8]; const float* log_dt = args.in[9];
    const float* b_re = args.in[10]; const float* b_im = args.in[11]; const float* c_re = args.in[12]; const float* c_im = args.in[13];
    const int tid = F.tid;
    LAS float* cof = Kt;
    if (tid < 64) {
        const int p = tid;
        const float dt = __expf(log_dt[g]);
        const float lr = a_re[g * SP + p], li = a_im[g * SP + p];
        const float mag = __expf(lr * dt);
        const double ph = (double)li * (double)dt; const double phr = ph - 6.283185307179586 * __builtin_rint(ph * 0.15915494309189535);
        const float sn = sinf((float)phr), cs = cosf((float)phr);
        const float ar = mag * cs, ai = mag * sn;
        const float nr = ar - 1.0f, ni = ai; const float den = lr * lr + li * li;
        cof[p * 2] = (nr * lr + ni * li) / den; cof[p * 2 + 1] = (ni * lr - nr * li) / den;
        double xr = 1.0, xi = 0.0;
        for (int k = 0; k <= 32; ++k) { pwr[p * 33 + k] = (float)xr; pwi[p * 33 + k] = (float)xi; const double t = xr * ar - xi * ai; xi = xr * ai + xi * ar; xr = t; }
        if (part == 0) { float* AL = WSP(float, ST_AL); AL[(g * SP + p) * 2] = pwr[p * 33 + 32]; AL[(g * SP + p) * 2 + 1] = pwi[p * 33 + 32]; }
    }
    __syncthreads();
    for (int i = tid; i < 64 * 16; i += NTHR) { const int p = i >> 4, c = i & 15; const float cr = cof[p * 2], ci = cof[p * 2 + 1];
        const float br = b_re[(g * SP + p) * SC + c], bi = b_im[(g * SP + p) * SC + c]; bbr[i] = cr * br - ci * bi; bbi[i] = cr * bi + ci * br; }
    for (int i = tid; i < 64 * 16; i += NTHR) { const int c = i >> 6, p = i & 63; ccr[p * 16 + c] = c_re[(g * SC + c) * SP + p]; cci[p * 16 + c] = c_im[(g * SC + c) * SP + p]; }
    __syncthreads();
    {
        const int lane = F.lane, co = lane & 15, kq = lane >> 4, h = kq & 1;
        float crv[32], civ[32], bv[32];
#pragma unroll
        for (int st = 0; st < 32; ++st) { const int p = (4 * st + kq) >> 1; crv[st] = ccr[p * 16 + co]; civ[st] = cci[p * 16 + co]; bv[st] = h ? bbi[p * 16 + co] : bbr[p * 16 + co]; }
        for (int kk = 0; kk < 4; ++kk) {
            const int k = F.wave * 4 + kk; f32x4 acc = (f32x4){0.f, 0.f, 0.f, 0.f};
#pragma unroll
            for (int st = 0; st < 32; ++st) {
                const int p = (4 * st + kq) >> 1; const float pr = pwr[p * 33 + k], pi = pwi[p * 33 + k];
                const float a = h ? -(crv[st] * pi + civ[st] * pr) : (crv[st] * pr - civ[st] * pi);
                acc = __builtin_amdgcn_mfma_f32_16x16x4f32(a, bv[st], acc, 0, 0, 0);
            }
#pragma unroll
            for (int r = 0; r < 4; ++r) Kt[(k * 16 + kq * 4 + r) * 16 + co] = acc[r];
        }
    }
    __syncthreads();
    bf16_t* BT2 = WSP(bf16_t, WS_BT2) + (size_t)g * 512 * KS5;
    for (int q = tid; q < 64 * 80; q += NTHR) {
        const int n = part * 64 + q / 80, ch = q % 80, tp = n >> 4, co = n & 15;
        float v[8];
        if (ch < 64) { const int tau = ch >> 1, ci0 = (ch & 1) * 8;
#pragma unroll
            for (int j = 0; j < 8; ++j) v[j] = (tau <= tp) ? Kt[((tp - tau) * 16 + co) * 16 + ci0 + j] : 0.f;
        } else { const int q0 = (ch - 64) * 8;
#pragma unroll
            for (int j = 0; j < 8; ++j) { const int qq = q0 + j, p = qq & 63; const float cr = ccr[p * 16 + co], ci = cci[p * 16 + co], pr = pwr[p * 33 + tp + 1], pi = pwi[p * 33 + tp + 1];
                v[j] = (qq < 64) ? (cr * pr - ci * pi) : -(cr * pi + ci * pr); }
        }
        u32x4 o; o.x = pk2(v[0], v[1]); o.y = pk2(v[2], v[3]); o.z = pk2(v[4], v[5]); o.w = pk2(v[6], v[7]);
        *(u32x4*)(BT2 + (size_t)n * KS5 + ch * 8) = o;
    }
    bf16_t* BT1 = WSP(bf16_t, WS_BT1) + (size_t)g * 256 * 512;
    for (int q = tid; q < 32 * 64; q += NTHR) {
        const int n = part * 32 + q / 64, ch = q % 64, tau = ch >> 1, ci0 = (ch & 1) * 8;
        float v[8];
#pragma unroll
        for (int j = 0; j < 8; ++j) {
            if (n < 128) { const int p = n & 63; const float pr = pwr[p * 33 + 31 - tau], pi = pwi[p * 33 + 31 - tau], br = bbr[p * 16 + ci0 + j], bi = bbi[p * 16 + ci0 + j];
                v[j] = (n < 64) ? (pr * br - pi * bi) : (pr * bi + pi * br); }
            else v[j] = 0.f;
        }
        u32x4 o; o.x = pk2(v[0], v[1]); o.y = pk2(v[2], v[3]); o.z = pk2(v[4], v[5]); o.w = pk2(v[6], v[7]);
        *(u32x4*)(BT1 + (size_t)n * 512 + ch * 8) = o;
    }
    __syncthreads();
}

template <class AT_> __device__ __forceinline__ void expert_items(const AT_& args, Frame& F, int w, int nw) {
    LAS unsigned* scr = (LAS unsigned*)(F.lds + F.wave * 16384);
    constexpr int I_GATE = NE * 64, I_UP = NE * 64, I_DOWN = NE * 64;
    for (int it = w; it < I_GATE + I_UP + I_DOWN; it += nw) {
        int r = it;
        if (r < I_GATE) { const int e = r / 64, q = r % 64, kb = q / 4, nb = q % 4, f0 = nb * 64; const int dst = (f0 >> 7) * 256 + (f0 & 127);
            transpose_item(args.in[25] + (size_t)e * D * FE, FE, kb * 64, f0, args.in[20], true, WSP(bf16_t, WS_WGU) + (size_t)e * 512 * D, D, dst, scr, F.lane); continue; } r -= I_GATE;
        if (r < I_UP) { const int e = r / 64, q = r % 64, kb = q / 4, nb = q % 4, f0 = nb * 64; const int dst = (f0 >> 7) * 256 + 128 + (f0 & 127);
            transpose_item(args.in[26] + (size_t)e * D * FE, FE, kb * 64, f0, args.in[20], true, WSP(bf16_t, WS_WGU) + (size_t)e * 512 * D, D, dst, scr, F.lane); continue; } r -= I_UP;
        { const int e = r / 64, q = r % 64, kb = q / 16, nb = q % 16;
            transpose_item(args.in[27] + (size_t)e * FE * D, D, kb * 64, nb * 64, args.in[27], false, WSP(bf16_t, WS_WD) + (size_t)e * D * FE, FE, nb * 64, scr, F.lane); }
    }
}
template <class AT_> __device__ __forceinline__ void p0_prologue(const AT_& args, Frame& F) {
    LAS unsigned* scr = (LAS unsigned*)(F.lds + F.wave * 16384);
    const int gw = F.bid * NWAVES + F.wave, NGW = F.G * NWAVES;
    constexpr int I_IN = 16 * 24, I_GLU = 8 * 16, I_OUT = 16 * 16, I_PG = 16 * 16, I_PPJ = 4 * 16;
    constexpr int NITEMS = I_IN + I_GLU + I_OUT + I_PG + I_PPJ;
    for (int it = gw; it < NITEMS; it += NGW) {
        int r = it;
        if (r < I_IN) { const int kb = r / 24, nb = r % 24; transpose_item(args.in[3], NPROJ, kb * 64, nb * 64, args.in[3], false, WSP(bf16_t, WS_WIN), D, nb * 64, scr, F.lane); continue; } r -= I_IN;
        if (r < I_GLU) { const int kb = r / 16, nb = r % 16, c0 = nb * 64; const int dst = (c0 < 512) ? ((c0 >> 7) * 256 + (c0 & 127)) : ((((c0 - 512) >> 7)) * 256 + 128 + ((c0 - 512) & 127));
            transpose_item(args.in[15], 2 * WB, kb * 64, c0, args.in[15], false, WSP(bf16_t, WS_WGLU), WB, dst, scr, F.lane); continue; } r -= I_GLU;
        if (r < I_OUT) { const int kb = r / 16, nb = r % 16;
            if (kb < 8) transpose_item(args.in[19], D, kb * 64, nb * 64, args.in[17], true, WSP(bf16_t, WS_WOUT), D, nb * 64, scr, F.lane);
            else transpose_item(args.in[19], D, kb * 64, nb * 64, args.in[18] - 512, true, WSP(bf16_t, WS_WOUT), D, nb * 64, scr, F.lane);
            continue; } r -= I_OUT;
        if (r < I_PG) { const int kb = r / 16, nb = r % 16; transpose_item(args.in[29], D, kb * 64, nb * 64, args.in[28], true, WSP(bf16_t, WS_WPG), D, nb * 64, scr, F.lane); continue; } r -= I_PG;
        { const int kb = r / 16, nb = r % 16; transpose_item(args.in[30], D, kb * 64, nb * 64, args.in[30], false, WSP(bf16_t, WS_WPP), PLE, nb * 64, scr, F.lane); }
    }
    const int gt = F.bid * NTHR + F.tid, NGT = F.G * NTHR;
    { bf16_t* WR = WSP(bf16_t, WS_WR); const float* wc = args.in[21]; const float* wf = args.in[23]; const float* g2 = args.in[20];
      for (int i = gt; i < 64 * D; i += NGT) { const int j = i >> 10, k = i & 1023; float v = 0.f;
          if (j < 4) v = wc[k * 4 + j]; else if (j < 36) { const int gg = (j - 4) >> 3, e = (j - 4) & 7; v = wf[((size_t)gg * D + k) * 8 + e]; }
          WR[i] = (bf16_t)f2bf(v * g2[k]); } }
    { bf16_t* WM = WSP(bf16_t, WS_WM); const float* wsp = args.in[5];
      for (int i = gt; i < HEADS * GCH * GCH; i += NGT) { const int t = (i >> 7) & 127, s = i & 127; WM[i] = (bf16_t)f2bf(s <= t ? wsp[i] : 0.f); } }
    { const f32x4* pp = (const f32x4*)args.in[1]; u32x2* PB = WSP(u32x2, WS_PB);
      for (int i = gt; i < M * PLE / 4; i += NGT) { const f32x4 v = pp[i]; u32x2 o; o.x = pk2(v.x, v.y); o.y = pk2(v.z, v.w); PB[i] = o; } }
    { const float* x = args.in[0]; const float* g1 = args.in[2]; bf16_t* XN = WSP(bf16_t, WS_A0);
      f32x4 gv[4];
#pragma unroll
      for (int j = 0; j < 4; ++j) gv[j] = ((const f32x4*)g1)[F.lane + 64 * j];
      for (int rp = 0; rp < (SUBREP == 3 ? 2 : 1); ++rp)
      for (int m = gw; m < M; m += NGW) {
          const f32x4* xr = (const f32x4*)(x + (size_t)m * D) + F.lane; f32x4 v[4]; float s = 0.f;
#pragma unroll
          for (int j = 0; j < 4; ++j) { v[j] = xr[64 * j]; s += (v[j].x * v[j].x + v[j].y * v[j].y) + (v[j].z * v[j].z + v[j].w * v[j].w); }
          const float r = rsqrtf(wave_sum(s) * (1.f / D) + EPS);
          u32x2* o8 = (u32x2*)(XN + (size_t)m * D) + F.lane;
#pragma unroll
          for (int j = 0; j < 4; ++j) { u32x2 o; o.x = pk2(v[j].x * r * gv[j].x, v[j].y * r * gv[j].y); o.y = pk2(v[j].z * r * gv[j].z, v[j].w * r * gv[j].w); o8[64 * j] = o; }
      } }
}

typedef f32x4 AccT[2][2][4][2];
struct EpiProj {
    static constexpr bool PERM = true; static constexpr int hook_t = -1;
    bf16_t* UG; bf16_t* VG; bf16_t* SH; float* VSS;
    __device__ __forceinline__ void mid(AccT&, int, int) const {}
    __device__ __forceinline__ void operator()(const AccT& acc, const Unit& u, int wr, int wc, int fr, int fq) const {
        const int kind = u.pn >> 1, cb = (u.pn & 1) * 256;
#pragma unroll
        for (int ai = 0; ai < 2; ++ai)
#pragma unroll
            for (int m = 0; m < 4; ++m) {
                const int row = u.pm * 256 + ai * 128 + wr * 64 + m * 16 + fr; float ss = 0.f;
#pragma unroll
                for (int bj = 0; bj < 2; ++bj) {
                    const int col = cb + bj * 128 + wc * 32 + fq * 8; f32x4 v0 = acc[ai][bj][m][0], v1 = acc[ai][bj][m][1];
                    if (kind < 2) {
                        v0 = (f32x4){gelu_t(v0[0]), gelu_t(v0[1]), gelu_t(v0[2]), gelu_t(v0[3])}; v1 = (f32x4){gelu_t(v1[0]), gelu_t(v1[1]), gelu_t(v1[2]), gelu_t(v1[3])};
                        ss += (v0[0] * v0[0] + v0[1] * v0[1]) + (v0[2] * v0[2] + v0[3] * v0[3]) + (v1[0] * v1[0] + v1[1] * v1[1]) + (v1[2] * v1[2] + v1[3] * v1[3]);
                    }
                    u32x4 w; w.x = pk2(v0[0], v0[1]); w.y = pk2(v0[2], v0[3]); w.z = pk2(v1[0], v1[1]); w.w = pk2(v1[2], v1[3]);
                    if (kind == 0) *(u32x4*)(UG + (size_t)row * WA + col) = w;
                    else if (kind == 1) *(u32x4*)(VG + (size_t)row * WA + col) = w;
                    else { const int g = col >> 4, ci0 = col & 15; *(u32x4*)(SH + ((size_t)(g * NCHK + (row >> 5)) * KS5 + (row & 31) * 16 + ci0)) = w; }
                }
                if (kind == 1) { ss += __shfl_xor(ss, 16); ss += __shfl_xor(ss, 32); if (fq == 0) VSS[row * 8 + (u.pn & 1) * 4 + wc] = ss; }
            }
    }
};
struct EpiS5a {
    static constexpr bool PERM = false; static constexpr int hook_t = -1;
    float* E;
    __device__ __forceinline__ void mid(AccT&, int, int) const {}
    __device__ __forceinline__ void operator()(const AccT& acc, const Unit& u, int wr, int wc, int fr, int fq) const {
#pragma unroll
        for (int ai = 0; ai < 2; ++ai)
#pragma unroll
            for (int m = 0; m < 4; ++m) { const int r = u.pm * 256 + ai * 128 + wr * 64 + m * 16 + fr; float* rowp = E + ((size_t)u.aux * NCHK + r) * 128 + wc * 32 + fq * 4;
#pragma unroll
                for (int n = 0; n < 2; ++n) *(f32x4*)(rowp + n * 16) = acc[ai][0][m][n]; }
    }
};
struct EpiS5b {
    static constexpr bool PERM = true; static constexpr int hook_t = -1;
    const bf16_t* SH; const float* dskip; bf16_t* Y2;
    __device__ __forceinline__ void mid(AccT&, int, int) const {}
    __device__ __forceinline__ void operator()(const AccT& acc, const Unit& u, int wr, int wc, int fr, int fq) const {
        const int g = u.aux;
#pragma unroll
        for (int bj = 0; bj < 2; ++bj) {
            const int n = u.pn * 256 + bj * 128 + wc * 32 + fq * 8, tp = n >> 4, co0 = n & 15;
            const f32x4 d0 = *(const f32x4*)(dskip + g * 16 + co0), d1 = *(const f32x4*)(dskip + g * 16 + co0 + 4);
#pragma unroll
            for (int ai = 0; ai < 2; ++ai)
#pragma unroll
                for (int m = 0; m < 4; ++m) {
                    const int r = u.pm * 256 + ai * 128 + wr * 64 + m * 16 + fr;
                    const u32x4 sv = *(const u32x4*)(SH + ((size_t)(g * NCHK + r) * KS5 + n));
                    const f32x4 v0 = acc[ai][bj][m][0], v1 = acc[ai][bj][m][1];
                    u32x4 w;
                    w.x = pk2(gelu_t(v0[0] + d0[0] * lo16(sv.x)), gelu_t(v0[1] + d0[1] * hi16(sv.x)));
                    w.y = pk2(gelu_t(v0[2] + d0[2] * lo16(sv.y)), gelu_t(v0[3] + d0[3] * hi16(sv.y)));
                    w.z = pk2(gelu_t(v1[0] + d1[0] * lo16(sv.z)), gelu_t(v1[1] + d1[1] * hi16(sv.z)));
                    w.w = pk2(gelu_t(v1[2] + d1[2] * lo16(sv.w)), gelu_t(v1[3] + d1[3] * hi16(sv.w)));
                    *(u32x4*)(Y2 + ((size_t)(r * SL + tp) * WB + g * 16 + co0)) = w;
                }
        }
    }
};
struct EpiGlu {
    static constexpr bool PERM = true; static constexpr int hook_t = -1;
    const float* bglu; bf16_t* MIX; float* OBSS;
    __device__ __forceinline__ void mid(AccT&, int, int) const {}
    __device__ __forceinline__ void operator()(const AccT& acc, const Unit& u, int wr, int wc, int fr, int fq) const {
        const int col = u.pn * 128 + wc * 32 + fq * 8;
        const f32x4 bv0 = *(const f32x4*)(bglu + col), bv1 = *(const f32x4*)(bglu + col + 4), bg0 = *(const f32x4*)(bglu + 512 + col), bg1 = *(const f32x4*)(bglu + 512 + col + 4);
#pragma unroll
        for (int ai = 0; ai < 2; ++ai)
#pragma unroll
            for (int m = 0; m < 4; ++m) {
                const int row = u.pm * 256 + ai * 128 + wr * 64 + m * 16 + fr;
                const f32x4 a0 = acc[ai][0][m][0] + bv0, a1 = acc[ai][0][m][1] + bv1, g0 = acc[ai][1][m][0] + bg0, g1 = acc[ai][1][m][1] + bg1;
                float o[8];
#pragma unroll
                for (int j = 0; j < 4; ++j) { o[j] = a0[j] * sigmoidf_(g0[j]); o[4 + j] = a1[j] * sigmoidf_(g1[j]); }
                float ss = 0.f;
#pragma unroll
                for (int j = 0; j < 8; ++j) ss += o[j] * o[j];
                u32x4 w; w.x = pk2(o[0], o[1]); w.y = pk2(o[2], o[3]); w.z = pk2(o[4], o[5]); w.w = pk2(o[6], o[7]);
                *(u32x4*)(MIX + (size_t)row * D + 512 + col) = w;
                ss += __shfl_xor(ss, 16); ss += __shfl_xor(ss, 32); if (fq == 0) OBSS[row * 16 + u.pn * 4 + wc] = ss;
            }
    }
};
struct EpiOut {
    static constexpr bool PERM = true; static constexpr int hook_t = 8;
    const float* x; bf16_t* HB; float* HSS; const LAS float* ra; const LAS float* rb;
    __device__ __forceinline__ void mid(AccT& acc, int wr, int fr) const {
#pragma unroll
        for (int ai = 0; ai < 2; ++ai)
#pragma unroll
            for (int m = 0; m < 4; ++m) { const int rl = ai * 128 + wr * 64 + m * 16 + fr; const float f = ra[rl] / rb[rl];
#pragma unroll
                for (int bj = 0; bj < 2; ++bj)
#pragma unroll
                    for (int n = 0; n < 2; ++n) acc[ai][bj][m][n] = acc[ai][bj][m][n] * f; }
    }
    __device__ __forceinline__ void operator()(const AccT& acc, const Unit& u, int wr, int wc, int fr, int fq) const {
#pragma unroll
        for (int ai = 0; ai < 2; ++ai)
#pragma unroll
            for (int m = 0; m < 4; ++m) {
                const int rl = ai * 128 + wr * 64 + m * 16 + fr, row = u.pm * 256 + rl; const float f = rb[rl]; float ss = 0.f;
#pragma unroll
                for (int bj = 0; bj < 2; ++bj) {
                    const int col = u.pn * 256 + bj * 128 + wc * 32 + fq * 8;
                    const f32x4 x0 = *(const f32x4*)(x + (size_t)row * D + col), x1 = *(const f32x4*)(x + (size_t)row * D + col + 4);
                    const f32x4 h0 = x0 + acc[ai][bj][m][0] * f, h1 = x1 + acc[ai][bj][m][1] * f;
                    ss += (h0[0] * h0[0] + h0[1] * h0[1]) + (h0[2] * h0[2] + h0[3] * h0[3]) + (h1[0] * h1[0] + h1[1] * h1[1]) + (h1[2] * h1[2] + h1[3] * h1[3]);
                    u32x4 w; w.x = pk2(h0[0], h0[1]); w.y = pk2(h0[2], h0[3]); w.z = pk2(h1[0], h1[1]); w.w = pk2(h1[2], h1[3]);
                    *(u32x4*)(HB + (size_t)row * D + col) = w;
                }
                ss += __shfl_xor(ss, 16); ss += __shfl_xor(ss, 32); if (fq == 0) HSS[row * 16 + u.pn * 4 + wc] = ss;
            }
    }
};
struct EpiBf {
    static constexpr bool PERM = true; static constexpr int hook_t = -1;
    bf16_t* O; int ldc;
    __device__ __forceinline__ void mid(AccT&, int, int) const {}
    __device__ __forceinline__ void operator()(const AccT& acc, const Unit& u, int wr, int wc, int fr, int fq) const {
#pragma unroll
        for (int ai = 0; ai < 2; ++ai)
#pragma unroll
            for (int m = 0; m < 4; ++m) { const int row = u.pm * 256 + ai * 128 + wr * 64 + m * 16 + fr;
#pragma unroll
                for (int bj = 0; bj < 2; ++bj) { const int col = u.pn * 256 + bj * 128 + wc * 32 + fq * 8; const f32x4 v0 = acc[ai][bj][m][0], v1 = acc[ai][bj][m][1];
                    u32x4 w; w.x = pk2(v0[0], v0[1]); w.y = pk2(v0[2], v0[3]); w.z = pk2(v1[0], v1[1]); w.w = pk2(v1[2], v1[3]);
                    *(u32x4*)(O + (size_t)row * ldc + col) = w; } }
    }
};
struct EpiGU {
    static constexpr bool PERM = true; static constexpr int hook_t = -1;
    const float* SR2; bf16_t* HH;
    __device__ __forceinline__ void mid(AccT&, int, int) const {}
    __device__ __forceinline__ void operator()(const AccT& acc, const Unit& u, int wr, int wc, int fr, int fq) const {
        const int col = u.pn * 128 + wc * 32 + fq * 8;
#pragma unroll
        for (int ai = 0; ai < 2; ++ai)
#pragma unroll
            for (int m = 0; m < 4; ++m) { const int row = u.pm * 256 + ai * 128 + wr * 64 + m * 16 + fr; const float r2 = SR2[row];
                const f32x4 g0 = acc[ai][0][m][0] * r2, g1 = acc[ai][0][m][1] * r2, u0 = acc[ai][1][m][0] * r2, u1 = acc[ai][1][m][1] * r2;
                float o[8];
#pragma unroll
                for (int j = 0; j < 4; ++j) { o[j] = g0[j] * sigmoidf_(g0[j]) * u0[j]; o[4 + j] = g1[j] * sigmoidf_(g1[j]) * u1[j]; }
                u32x4 w; w.x = pk2(o[0], o[1]); w.y = pk2(o[2], o[3]); w.z = pk2(o[4], o[5]); w.w = pk2(o[6], o[7]);
                *(u32x4*)(HH + (size_t)row * FE + col) = w; }
    }
};
struct EpiDown {
    static constexpr bool PERM = true; static constexpr int hook_t = -1;
    const float* SW; bf16_t* YE;
    __device__ __forceinline__ void mid(AccT&, int, int) const {}
    __device__ __forceinline__ void operator()(const AccT& acc, const Unit& u, int wr, int wc, int fr, int fq) const {
#pragma unroll
        for (int ai = 0; ai < 2; ++ai)
#pragma unroll
            for (int m = 0; m < 4; ++m) { const int row = u.pm * 256 + ai * 128 + wr * 64 + m * 16 + fr; const float wgt = SW[row];
#pragma unroll
                for (int bj = 0; bj < 2; ++bj) { const int col = u.pn * 256 + bj * 128 + wc * 32 + fq * 8; const f32x4 v0 = acc[ai][bj][m][0] * wgt, v1 = acc[ai][bj][m][1] * wgt;
                    u32x4 w; w.x = pk2(v0[0], v0[1]); w.y = pk2(v0[2], v0[3]); w.z = pk2(v1[0], v1[1]); w.w = pk2(v1[2], v1[3]);
                    *(u32x4*)(YE + (size_t)row * D + col) = w; } }
    }
};
struct EpiPle {
    static constexpr bool PERM = false; static constexpr int hook_t = -1;
    const bf16_t* H2B; const bf16_t* PP; const float* R3; float* out; float* FSS;
    __device__ __forceinline__ void mid(AccT&, int, int) const {}
    __device__ __forceinline__ void operator()(const AccT& acc, const Unit& u, int wr, int wc, int fr, int fq) const {
#pragma unroll
        for (int ai = 0; ai < 2; ++ai)
#pragma unroll
            for (int m = 0; m < 4; ++m) { const int row = u.pm * 256 + ai * 128 + wr * 64 + m * 16 + fr; const float r3 = R3[row]; float ss = 0.f;
#pragma unroll
                for (int bj = 0; bj < 2; ++bj)
#pragma unroll
                    for (int n = 0; n < 2; ++n) { const int col = u.pn * 256 + bj * 128 + wc * 32 + n * 16 + fq * 4; const size_t off = (size_t)row * D + col;
                        const u32x2 hv = *(const u32x2*)(H2B + off), pv = *(const u32x2*)(PP + off); const f32x4 a = acc[ai][bj][m][n];
                        f32x4 o; o[0] = lo16(hv.x) + sigmoidf_(a[0] * r3) * lo16(pv.x); o[1] = hi16(hv.x) + sigmoidf_(a[1] * r3) * hi16(pv.x);
                        o[2] = lo16(hv.y) + sigmoidf_(a[2] * r3) * lo16(pv.y); o[3] = hi16(hv.y) + sigmoidf_(a[3] * r3) * hi16(pv.y);
                        ss += (o[0] * o[0] + o[1] * o[1]) + (o[2] * o[2] + o[3] * o[3]);
                        *(f32x4*)(out + off) = o; }
                ss += __shfl_xor(ss, 16); ss += __shfl_xor(ss, 32); if (fq == 0) FSS[row * 16 + u.pn * 4 + wc] = ss; }
    }
};

struct S5Order {
    const char* SH; const char* BT; int npn, nrowsB, ldb, G, c;
    __device__ bool next(int i, Unit& u) const {
        const int L = i * G + c; if (L >= SG * npn * 2) return false;
        const int g = L / (npn * 2), rem = L % (npn * 2); u.pn = rem >> 1; u.pm = rem & 1; u.aux = g;
        u.A = SH + (size_t)(g * NCHK + u.pm * 256) * KS5 * 2; u.B = BT + (size_t)(g * nrowsB + u.pn * 256) * ldb * 2; return true;
    }
};
struct OneUnit { Unit u; __device__ bool next(int i, Unit& o) const { if (i) return false; o = u; return true; } };
struct MoeOrder {
    const char* Abase; size_t tA; const char* Bbase; size_t eB, tB; const LAS int* tb; int npn, G, c;
    __device__ bool next(int i, Unit& u) const {
        const int L = i * G + c; const int ntile = __builtin_amdgcn_readfirstlane(tb[NE]);
        if (L >= ntile * npn) return false;
        const int tile = L / npn; u.pn = L % npn; u.pm = tile; int e = 0;
        for (int j = 1; j < NE; ++j) e += (__builtin_amdgcn_readfirstlane(tb[j]) <= tile) ? 1 : 0;
        u.aux = e; u.A = Abase + (size_t)tile * tA; u.B = Bbase + (size_t)e * eB + (size_t)u.pn * tB; return true;
    }
};

template <class AT_> __device__ __forceinline__ void gmlp_unit(const AT_& args, Frame& F, int c, int h) {
    LAS bf16_t* vnT = (LAS bf16_t*)F.lds;
    LAS float* rv = (LAS float*)(F.lds + 64 * 136 * 2);
    const bf16_t* VG = DOP(bf16_t, DO_VG); const bf16_t* UG = DOP(bf16_t, DO_UG); const float* VSS = WSP(float, ST_VSS);
    const bf16_t* WM = WSP(bf16_t, WS_WM); bf16_t* MIX = WSP(bf16_t, WS_MIX); float* OASS = WSP(float, ST_OASS);
    const float* sgu = args.in[4]; const float* bsp = args.in[6];
    const int tid = F.tid, row0 = c * GCH;
    if (tid < 128) { const f32x4* p = (const f32x4*)(VSS + (size_t)(row0 + tid) * 8); const f32x4 a = p[0], b = p[1];
        rv[tid] = rsqrtf(((a[0] + a[1]) + (a[2] + a[3]) + (b[0] + b[1]) + (b[2] + b[3])) * (1.f / WA) + EPS); }
    __syncthreads();
    {
        const int s = tid >> 2, dq = (tid & 3) * 16; const float r = rv[s];
        const u32x4 a = *(const u32x4*)(VG + (size_t)(row0 + s) * WA + h * DH + dq), b = *(const u32x4*)(VG + (size_t)(row0 + s) * WA + h * DH + dq + 8);
        const unsigned w[8] = {a.x, a.y, a.z, a.w, b.x, b.y, b.z, b.w};
#pragma unroll
        for (int j = 0; j < 8; ++j) { const int d = dq + 2 * j; const float g0 = sgu[h * DH + d], g1 = sgu[h * DH + d + 1];
            vnT[d * 136 + s] = (bf16_t)f2bf(lo16(w[j]) * r * g0); vnT[(d + 1) * 136 + s] = (bf16_t)f2bf(hi16(w[j]) * r * g1); }
    }
    __syncthreads();
    const int wv = F.wave, lane = F.lane, dtile = wv & 1, ttile = wv >> 1, r = lane & 31, hh = lane >> 5;
    f32x16 acc;
#pragma unroll
    for (int i = 0; i < 16; ++i) acc[i] = 0.f;
    const int nks = 2 * (ttile + 1);
    const bf16_t* wrow = WM + ((size_t)(h * GCH + ttile * 32 + r) * GCH + 8 * hh);
    const LAS bf16_t* arow = vnT + (dtile * 32 + r) * 136 + 8 * hh;
    for (int ks = 0; ks < nks; ++ks) {
        const bf16x8 a = *(const LAS bf16x8*)(arow + ks * 16);
        const bf16x8 b = *(const bf16x8*)(wrow + ks * 16);
        acc = __builtin_amdgcn_mfma_f32_32x32x16_bf16(a, b, acc, 0, 0, 0);
    }
    const int t = ttile * 32 + r, row = row0 + t; const float bias = bsp[h * GCH + t]; float ss = 0.f;
#pragma unroll
    for (int gq = 0; gq < 4; ++gq) {
        const int d0 = dtile * 32 + 8 * gq + 4 * hh; const size_t uoff = (size_t)row * WA + h * DH + d0;
        const u32x2 uv = *(const u32x2*)(UG + uoff);
        const float o0 = lo16(uv.x) * (acc[4 * gq + 0] + bias), o1 = hi16(uv.x) * (acc[4 * gq + 1] + bias), o2 = lo16(uv.y) * (acc[4 * gq + 2] + bias), o3 = hi16(uv.y) * (acc[4 * gq + 3] + bias);
        ss += (o0 * o0 + o1 * o1) + (o2 * o2 + o3 * o3);
        u32x2 w; w.x = pk2(o0, o1); w.y = pk2(o2, o3);
        *(u32x2*)(MIX + (size_t)row * D + h * DH + d0) = w;
    }
    ss += __shfl_xor(ss, 32);
    if (hh == 0) OASS[row * 16 + h * 2 + dtile] = ss;
    __syncthreads();
}

__device__ __forceinline__ void s5_scan(Frame& F) {
    const int idx = F.bid * NTHR + F.tid; if (idx >= 4 * SG * SP) return;
    const int p = idx & 63, g = (idx >> 6) & 31, b = idx >> 11;
    const float* AL = WSP(float, ST_AL); const float ar = AL[(g * SP + p) * 2], ai = AL[(g * SP + p) * 2 + 1];
    const float* E = DOP(float, DO_E) + ((size_t)g * NCHK + b * CPB) * 128;
    bf16_t* SH = DOP(bf16_t, DO_SH) + ((size_t)g * NCHK + b * CPB) * KS5 + 512;
    float hr = 0.f, hi = 0.f;
    for (int j0 = 0; j0 < CPB; j0 += 8) {
        float er[8], ei[8];
#pragma unroll
        for (int j = 0; j < 8; ++j) { er[j] = E[(size_t)(j0 + j) * 128 + p]; ei[j] = E[(size_t)(j0 + j) * 128 + 64 + p]; }
#pragma unroll
        for (int j = 0; j < 8; ++j) {
            SH[(size_t)(j0 + j) * KS5 + p] = (bf16_t)f2bf(hr); SH[(size_t)(j0 + j) * KS5 + 64 + p] = (bf16_t)f2bf(hi);
            const float nr = ar * hr - ai * hi + er[j]; hi = ar * hi + ai * hr + ei[j]; hr = nr;
        }
    }
}

template <class AT_> __device__ __forceinline__ void router_phase(const AT_& args, Frame& F, unsigned* CNT) {
    constexpr int WRS = 1032;
    LAS bf16_t* WrL = (LAS bf16_t*)F.lds;
    LAS float* LG = (LAS float*)(F.lds + 48 * WRS * 2);
    LAS int* hist = (LAS int*)(F.lds + 48 * WRS * 2 + 2 * 64 * 48 * 4);
    const bf16_t* WR = WSP(bf16_t, WS_WR); const bf16_t* HB = DOP(bf16_t, DO_HB); const float* HSS = WSP(float, ST_HSS);
    const float* bc = args.in[22]; const float* bfine = args.in[24];
    float* R2 = WSP(float, ST_R2); int* RE = WSP(int, ST_RE); float* RW = WSP(float, ST_RW); int* RP = WSP(int, ST_SLOT); int* TOK = WSP(int, ST_TOK);
    const int tid = F.tid, lane = F.lane, wv = F.wave;
    for (int i = tid; i < 48 * 128; i += NTHR) { const int rr = i >> 7, ch = i & 127; *(LAS u32x4*)(WrL + rr * WRS + ch * 8) = *(const u32x4*)(WR + (size_t)rr * D + ch * 8); }
    __syncthreads();
    const int mt = wv & 3, kh = wv >> 2, fr = lane & 15, fq = lane >> 4;
    for (int unit = F.bid; unit < M / 64; unit += F.G) {
        const int row0 = unit * 64;
        if (tid < 64) hist[tid] = 0;
        f32x4 acc[3];
#pragma unroll
        for (int n = 0; n < 3; ++n) acc[n] = (f32x4){0.f, 0.f, 0.f, 0.f};
        const bf16_t* arow = HB + (size_t)(row0 + mt * 16 + fr) * D + kh * 512 + fq * 8;
#pragma unroll 4
        for (int ks = 0; ks < 16; ++ks) {
            const bf16x8 a = *(const bf16x8*)(arow + ks * 32);
#pragma unroll
            for (int n = 0; n < 3; ++n) { const bf16x8 b = *(const LAS bf16x8*)(WrL + (n * 16 + fr) * WRS + kh * 512 + ks * 32 + fq * 8);
                acc[n] = __builtin_amdgcn_mfma_f32_16x16x32_bf16(a, b, acc[n], 0, 0, 0); }
        }
#pragma unroll
        for (int n = 0; n < 3; ++n)
#pragma unroll
            for (int j = 0; j < 4; ++j) LG[(kh * 64 + mt * 16 + fq * 4 + j) * 48 + n * 16 + fr] = acc[n][j];
        __syncthreads();
        int e1 = 0, e2 = 0, l1 = 0, l2 = 0; float w1 = 0.f, w2 = 0.f, r2 = 0.f; const int row = row0 + tid;
        if (tid < 64) {
            const f32x4* hp = (const f32x4*)(HSS + (size_t)row * 16); const f32x4 s0 = hp[0], s1 = hp[1], s2 = hp[2], s3 = hp[3];
            const float ssum = ((s0[0] + s0[1]) + (s0[2] + s0[3])) + ((s1[0] + s1[1]) + (s1[2] + s1[3])) + ((s2[0] + s2[1]) + (s2[2] + s2[3])) + ((s3[0] + s3[1]) + (s3[2] + s3[3]));
            r2 = rsqrtf(ssum * (1.f / D) + EPS);
            const LAS float* lg0 = LG + tid * 48; const LAS float* lg1 = LG + (64 + tid) * 48;
            float lc[4]; int gs = 0; float lmax;
#pragma unroll
            for (int j = 0; j < 4; ++j) lc[j] = (lg0[j] + lg1[j]) * r2 + bc[j];
            lmax = lc[0];
#pragma unroll
            for (int j = 1; j < 4; ++j) if (lc[j] > lmax) { lmax = lc[j]; gs = j; }
            float den = 0.f;
#pragma unroll
            for (int j = 0; j < 4; ++j) den += __expf(lc[j] - lmax);
            const float pg = 1.0f / den;
            float lf[8];
#pragma unroll
            for (int j = 0; j < 8; ++j) lf[j] = (lg0[4 + gs * 8 + j] + lg1[4 + gs * 8 + j]) * r2 + bfine[gs * 8 + j];
            int i1 = 0; float m1 = lf[0];
#pragma unroll
            for (int j = 1; j < 8; ++j) if (lf[j] > m1) { m1 = lf[j]; i1 = j; }
            int i2 = -1; float m2 = -3.0e38f;
#pragma unroll
            for (int j = 0; j < 8; ++j) if (j != i1 && lf[j] > m2) { m2 = lf[j]; i2 = j; }
            const float q2 = __expf(m2 - m1); const float inv = pg / (1.0f + q2);
            w1 = inv; w2 = q2 * inv; e1 = gs * 8 + i1; e2 = gs * 8 + i2;
            l1 = atomicAdd((int*)&hist[e1], 1); l2 = atomicAdd((int*)&hist[e2], 1);
        }
        __syncthreads();
        if (tid < 32) hist[32 + tid] = (int)atomicAdd(&CNT[tid], (unsigned)hist[tid]);
        __syncthreads();
        if (tid < 64) {
            const int p1 = hist[32 + e1] + l1, p2 = hist[32 + e2] + l2;
            TOK[(size_t)e1 * M + p1] = row; TOK[(size_t)e2 * M + p2] = row;
            RE[row * 2] = e1; RE[row * 2 + 1] = e2; RP[row * 2] = p1; RP[row * 2 + 1] = p2; RW[row * 2] = w1; RW[row * 2 + 1] = w2; R2[row] = r2;
        }
        __syncthreads();
    }
}

__device__ __forceinline__ void moe_tiles(Frame& F, const unsigned* CNT) {
    LAS int* tb = (LAS int*)(F.lds + AUX_TB);
    if (F.tid == 0) { int t = 0; for (int e = 0; e < NE; ++e) { tb[e] = t; t += ((int)__hip_atomic_load(CNT + e, __ATOMIC_RELAXED, __HIP_MEMORY_SCOPE_AGENT) + 255) >> 8; } tb[NE] = t; }
    __syncthreads();
}

__device__ __forceinline__ void gather_phase(Frame& F, const unsigned* CNT) {
    const LAS int* tb = (const LAS int*)(F.lds + AUX_TB);
    const bf16_t* HB = DOP(bf16_t, DO_HB); bf16_t* XS = WSP(bf16_t, WS_XS);
    const int* TOK = WSP(int, ST_TOK); const int* RE = WSP(int, ST_RE); const float* RW = WSP(float, ST_RW); const float* R2 = WSP(float, ST_R2);
    float* SW = WSP(float, ST_SW); float* SR2 = WSP(float, ST_SR2);
    const int gw = F.bid * NWAVES + F.wave, NGW = F.G * NWAVES; const int nrows = tb[NE] * 256;
    for (int sr = gw; sr < nrows; sr += NGW) {
        const int tile = sr >> 8; int e = 0;
        for (int j = 1; j < NE; ++j) e += (tb[j] <= tile) ? 1 : 0;
        const int pos = sr - tb[e] * 256; const int ne = (int)CNT[e];
        u32x4 v0 = (u32x4){0u, 0u, 0u, 0u}, v1 = v0;
        if (pos < ne) {
            const int tok = TOK[(size_t)e * M + pos];
            const u32x4* src = (const u32x4*)(HB + (size_t)tok * D); v0 = src[F.lane]; v1 = src[64 + F.lane];
            if (F.lane == 0) { const int k = (RE[tok * 2] == e) ? 0 : 1; SW[sr] = RW[tok * 2 + k]; SR2[sr] = R2[tok]; }
        } else if (F.lane == 0) { SW[sr] = 0.f; SR2[sr] = 0.f; }
        u32x4* dst = (u32x4*)(XS + (size_t)sr * D); dst[F.lane] = v0; dst[64 + F.lane] = v1;
    }
}

constexpr int NPHASE = 13;
template <int K, class AT_> __device__ __forceinline__ void phase_body(const AT_& args, Frame& F) {
    LAS unsigned char* ring = F.lds; const int c = F.bid; unsigned* CNT = (unsigned*)(F.ws + WS_CTL) + CW_CNT; (void)ring; (void)c; (void)CNT;
    if constexpr (K == 0) { p0_prologue(args, F);
    }
    if constexpr (K == 1) {
        pg8::DenseOrder S; S.init(WSP(bf16_t, WS_A0), D, WSP(bf16_t, WS_WIN), D, M, NPROJ, F.G, c);
        EpiProj E{DOP(bf16_t, DO_UG), DOP(bf16_t, DO_VG), DOP(bf16_t, DO_SH), WSP(float, ST_VSS)};
        pg8::gemm_phase<EpiProj, pg8::DenseOrder, true, false>(ring, pg8::Gemm{D, D, 16}, S, E);
        { const int nidle = F.G - 128; if (nidle > 0) { if (c >= 128) for (int u = c - 128; u < SG * 8; u += nidle) s5_precompute(args, F, u >> 3, u & 7); }
          else for (int u = c; u < SG * 8; u += F.G) s5_precompute(args, F, u >> 3, u & 7); }
    }
    if constexpr (K == 2) {
        for (int u = F.bid; u < (M / GCH) * HEADS; u += F.G) gmlp_unit(args, F, u >> 3, u & 7);
        S5Order S{(const char*)DOP(bf16_t, DO_SH), (const char*)WSP(bf16_t, WS_BT1), 1, 256, 512, F.G, c};
        EpiS5a E{DOP(float, DO_E)};
        pg8::gemm_phase<EpiS5a, S5Order, true, false>(ring, pg8::Gemm{KS5, 512, 8}, S, E);
    }
    if constexpr (K == 3) {
        s5_scan(F);
        pg8::DenseOrder S; S.init(WSP(bf16_t, WS_PB), PLE, WSP(bf16_t, WS_WPP), PLE, M, D, F.G, c);
        EpiBf E{WSP(bf16_t, WS_PP), D};
        pg8::gemm_phase<EpiBf, pg8::DenseOrder, true, false>(ring, pg8::Gemm{PLE, PLE, 4}, S, E);
    }
    if constexpr (K == 4) {
        S5Order S{(const char*)DOP(bf16_t, DO_SH), (const char*)WSP(bf16_t, WS_BT2), 2, 512, KS5, F.G, c};
        EpiS5b E{DOP(bf16_t, DO_SH), args.in[14], WSP(bf16_t, WS_Y2)};
        pg8::gemm_phase<EpiS5b, S5Order, true, false>(ring, pg8::Gemm{KS5, KS5, 10}, S, E);
        { const int nidle = F.G - 128; if (nidle > 0) { if (c >= 128) expert_items(args, F, (c - 128) * NWAVES + F.wave, nidle * NWAVES); }
          else expert_items(args, F, c * NWAVES + F.wave, F.G * NWAVES); }
    }
    if constexpr (K == 5) {
        pg8::DenseOrder S; S.init(WSP(bf16_t, WS_Y2), WB, WSP(bf16_t, WS_WGLU), WB, M, 2 * WB, F.G, c);
        EpiGlu E{args.in[16], WSP(bf16_t, WS_MIX), WSP(float, ST_OBSS)};
        pg8::gemm_phase<EpiGlu, pg8::DenseOrder, true, false>(ring, pg8::Gemm{WB, WB, 8}, S, E);
    }
    if constexpr (K == 6) {
        pg8::DenseOrder S; S.init(WSP(bf16_t, WS_MIX), D, WSP(bf16_t, WS_WOUT), D, M, D, F.G, c);
        LAS float* ra = (LAS float*)(F.lds + AUX_RA); LAS float* rb = (LAS float*)(F.lds + AUX_RB);
        EpiOut E{args.in[0], DOP(bf16_t, DO_HB), WSP(float, ST_HSS), ra, rb};
        for (int i = 0;; ++i) {
            Unit u; if (!S.next(i, u)) break;
            __syncthreads();
            if (F.tid < 256) { const int row = u.pm * 256 + F.tid; const f32x4* pa = (const f32x4*)(WSP(float, ST_OASS) + (size_t)row * 16); const f32x4* pb = (const f32x4*)(WSP(float, ST_OBSS) + (size_t)row * 16);
                float sa = 0.f, sb = 0.f;
#pragma unroll
                for (int j = 0; j < 4; ++j) { const f32x4 a = pa[j], b = pb[j]; sa += (a[0] + a[1]) + (a[2] + a[3]); sb += (b[0] + b[1]) + (b[2] + b[3]); }
                ra[F.tid] = rsqrtf(sa * (1.f / WA) + EPS); rb[F.tid] = rsqrtf(sb * (1.f / WB) + EPS); }
            __syncthreads();
            OneUnit O{u};
            pg8::gemm_phase<EpiOut, OneUnit, false, true>(ring, pg8::Gemm{D, D, 16}, O, E);
        }
    }
    if constexpr (K == 7) { router_phase(args, F, CNT);
    }
    if constexpr (K == 8) { moe_tiles(F, CNT); gather_phase(F, CNT);
    }
    if constexpr (K == 9) {
        moe_tiles(F, CNT);
        MoeOrder S{(const char*)WSP(bf16_t, WS_XS), (size_t)256 * D * 2, (const char*)WSP(bf16_t, WS_WGU), (size_t)512 * D * 2, (size_t)256 * D * 2, (const LAS int*)(F.lds + AUX_TB), 2, F.G, c};
        EpiGU E{WSP(float, ST_SR2), DOP(bf16_t, DO_HH)};
        pg8::gemm_phase<EpiGU, MoeOrder, true, false>(ring, pg8::Gemm{D, D, 16}, S, E);
    }
    if constexpr (K == 10) {
        moe_tiles(F, CNT);
        MoeOrder S{(const char*)DOP(bf16_t, DO_HH), (size_t)256 * FE * 2, (const char*)WSP(bf16_t, WS_WD), (size_t)D * FE * 2, (size_t)256 * FE * 2, (const LAS int*)(F.lds + AUX_TB), 4, F.G, c};
        EpiDown E{WSP(float, ST_SW), WSP(bf16_t, WS_XS)};
        pg8::gemm_phase<EpiDown, MoeOrder, true, false>(ring, pg8::Gemm{FE, FE, 4}, S, E);
    }
    if constexpr (K == 11) {
        moe_tiles(F, CNT);
        const LAS int* tb = (const LAS int*)(F.lds + AUX_TB);
        const bf16_t* HB = DOP(bf16_t, DO_HB); const bf16_t* YE = WSP(bf16_t, WS_XS); bf16_t* H2B = WSP(bf16_t, WS_A0);
        const int* RE = WSP(int, ST_RE); const int* RP = WSP(int, ST_SLOT); float* R3 = WSP(float, ST_R3);
        const int gw = F.bid * NWAVES + F.wave, NGW = F.G * NWAVES;
        for (int m = gw; m < M; m += NGW) {
            const int e1 = RE[m * 2], e2 = RE[m * 2 + 1]; const int s1 = tb[e1] * 256 + RP[m * 2], s2 = tb[e2] * 256 + RP[m * 2 + 1];
            const u32x4* ph = (const u32x4*)(HB + (size_t)m * D); const u32x4* p1 = (const u32x4*)(YE + (size_t)s1 * D); const u32x4* p2 = (const u32x4*)(YE + (size_t)s2 * D);
            float ss = 0.f;
#pragma unroll
            for (int j = 0; j < 2; ++j) {
                const u32x4 a = ph[F.lane + 64 * j], b = p1[F.lane + 64 * j], cc = p2[F.lane + 64 * j];
                const unsigned aw[4] = {a.x, a.y, a.z, a.w}, bw[4] = {b.x, b.y, b.z, b.w}, cw[4] = {cc.x, cc.y, cc.z, cc.w}; unsigned ow[4];
#pragma unroll
                for (int q = 0; q < 4; ++q) { const float lo = lo16(aw[q]) + lo16(bw[q]) + lo16(cw[q]), hi_ = hi16(aw[q]) + hi16(bw[q]) + hi16(cw[q]); ss += lo * lo + hi_ * hi_; ow[q] = pk2(lo, hi_); }
                ((u32x4*)(H2B + (size_t)m * D))[F.lane + 64 * j] = (u32x4){ow[0], ow[1], ow[2], ow[3]};
            }
            ss = wave_sum(ss);
            if (F.lane == 0) R3[m] = rsqrtf(ss * (1.f / D) + EPS);
        }
    }
    if constexpr (K == 12) {
        pg8::DenseOrder S; S.init(WSP(bf16_t, WS_A0), D, WSP(bf16_t, WS_WPG), D, M, D, F.G, c);
        EpiPle E{WSP(bf16_t, WS_A0), WSP(bf16_t, WS_PP), WSP(float, ST_R3), args.out, WSP(float, ST_FSS)};
        pg8::gemm_phase<EpiPle, pg8::DenseOrder, true, false>(ring, pg8::Gemm{D, D, 16}, S, E);
    }
    if constexpr (K == 13) {
        const float* FSS = WSP(float, ST_FSS); const float* gf = args.in[31]; float* out = args.out;
        const int gw = F.bid * NWAVES + F.wave, NGW = F.G * NWAVES;
        f32x4 gv[4];
#pragma unroll
        for (int j = 0; j < 4; ++j) gv[j] = ((const f32x4*)gf)[F.lane + 64 * j];
        for (int m = gw; m < M; m += NGW) {
            const float sv = (F.lane < 16) ? FSS[(size_t)m * 16 + F.lane] : 0.f; const float r = rsqrtf(wave_sum(sv) * (1.f / D) + EPS);
            f32x4* o = (f32x4*)(out + (size_t)m * D) + F.lane;
#pragma unroll
            for (int j = 0; j < 4; ++j) { f32x4 v = o[64 * j]; v = v * r * gv[j]; o[64 * j] = v; }
        }
    }
}

__global__ void __launch_bounds__(NTHR, 2) mk_fwd(Args args) {
    extern __shared__ __attribute__((aligned(16))) unsigned char lds_raw[];
    Frame F;
    F.lds = (LAS unsigned char*)lds_raw; F.tid = threadIdx.x; F.lane = F.tid & 63; F.wave = __builtin_amdgcn_readfirstlane(F.tid >> 6);
    F.G = gridDim.x; F.bid = blockIdx.x;
    F.ws = args.ws; F.dout = (unsigned char*)args.out;
    unsigned* ctl = (unsigned*)(F.ws + WS_CTL);
    for (int u = F.tid; u < (LDS_BYTES - AUX_OFF) / 4; u += NTHR) ((LAS unsigned*)(F.lds + AUX_OFF))[u] = 0u;
    __syncthreads();
    XcdBarrier bar; bar.bar = ctl + CW_BAR; bar.x = 0; bar.st = nullptr;
#if !MK_PER_PHASE
    bar = xcd_barrier_post(ctl + CW_BAR, (volatile LAS unsigned*)(F.lds + AUX_MISC) + 8);
#endif
    const int lo = args.ph_lo, hi = args.ph_hi;
#ifndef PHMASK
#define PHMASK 0xFFFF
#endif
#define IN(k) ((((PHMASK) >> (k)) & 1) && lo <= (k) && (k) < hi)
#if MK_PER_PHASE
#define SEAM(k) do { } while (0)
#else
#define SEAM(k) do { if (IN(k) && IN((k) + 1)) xcd_barrier(bar); } while (0)
#endif
    typedef const Args __attribute__((address_space(4))) KArgs;
    KArgs* const kargs_ = (KArgs*)__builtin_amdgcn_kernarg_segment_ptr();
#define RUNP(k) do { Frame Fp_ = F; KArgs* ap_ = kargs_; asm volatile("" : "+s"(Fp_.ws), "+s"(Fp_.dout), "+s"(ap_)); phase_body<k>(*ap_, Fp_); } while (0)
#define PH(k) if (IN(k)) { RUNP(k); if (PHREP == (k)) { xcd_barrier(bar); RUNP(k); } } SEAM(k);
    PH(0) PH(1) PH(2) PH(3) PH(4) PH(5) PH(6) PH(7) PH(8) PH(9) PH(10) PH(11) PH(12) PH(13)
#undef IN
#undef SEAM
}

extern "C" void kernel_launch(void* const* d_in, const int* in_sizes, int n_in, void* d_out, int out_size, void* d_ws, size_t ws_size, hipStream_t stream) {
    static int grid = 0;
    if (grid == 0) {
        if (n_in != 32 || in_sizes[0] != M * D || out_size != M * D || ws_size < WS_END) { fprintf(stderr, "kernel_launch: unexpected shapes (n_in %d, in0 %d, out %d, ws %zu, need %zu)\n", n_in, n_in > 0 ? in_sizes[0] : -1, out_size, ws_size, (size_t)WS_END); grid = -1; return; }
        int dev = 0, cus = 0, per_cu = 0;
        if (hipGetDevice(&dev) != hipSuccess || hipDeviceGetAttribute(&cus, hipDeviceAttributeMultiprocessorCount, dev) != hipSuccess) { grid = -1; return; }
        if (hipFuncSetAttribute((const void*)mk_fwd, hipFuncAttributeMaxDynamicSharedMemorySize, LDS_BYTES) != hipSuccess) { fprintf(stderr, "kernel_launch: hipFuncSetAttribute failed\n"); grid = -1; return; }
        if (hipOccupancyMaxActiveBlocksPerMultiprocessor(&per_cu, (const void*)mk_fwd, NTHR, LDS_BYTES) != hipSuccess || per_cu < 1) { fprintf(stderr, "kernel_launch: occupancy query says %d\n", per_cu); (void)hipGetLastError(); per_cu = 1; }
        grid = cus;
    }
    if (grid < 0) return;
    (void)hipMemsetAsync((char*)d_ws + WS_CTL, 0, CTL_ZERO, stream);
    Args a{};
    for (int i = 0; i < 32; ++i) a.in[i] = (const float*)d_in[i];
    a.out = (float*)d_out; a.ws = (unsigned char*)d_ws;
#if MK_PER_PHASE
    for (int ph = 0; ph <= NPHASE; ++ph) { a.ph_lo = ph; a.ph_hi = ph + 1; hipLaunchKernelGGL(mk_fwd, dim3(grid), dim3(NTHR), LDS_BYTES, stream, a); }
#else
    a.ph_lo = 0; a.ph_hi = NPHASE + 1;
    hipLaunchKernelGGL(mk_fwd, dim3(grid), dim3(NTHR), LDS_BYTES, stream, a);
#endif
}
```

```cpp
#include <hip/hip_runtime.h>
#include <cstdio>
#include <cstdint>

#ifndef MK_PER_PHASE
#define MK_PER_PHASE 0
#endif

#define PHREP (-1)
#define SUBREP (0)

#define LAS __attribute__((address_space(3)))
#define GAS __attribute__((address_space(1)))
typedef unsigned short bf16_t;
typedef short bf16x8 __attribute__((ext_vector_type(8)));
typedef float f32x4 __attribute__((ext_vector_type(4)));
typedef float f32x16 __attribute__((ext_vector_type(16)));
typedef unsigned u32x4 __attribute__((ext_vector_type(4)));
typedef unsigned u32x2 __attribute__((ext_vector_type(2)));

constexpr int M = 16384, D = 1024, WA = 512, WB = 512, NPROJ = 1536;
constexpr int SEQ = 4096;
constexpr int GCH = 128, HEADS = 8, DH = 64;
constexpr int SG = 32, SC = 16, SP = 64;
constexpr int SL = 32;
constexpr int NCHK = M / SL;
constexpr int CPB = SEQ / SL;
constexpr int KS5 = SL * SC + 2 * SP;
constexpr int NE = 32, FE = 256, EPG = 8, NGRP = 4;
constexpr int PLE = 256;
constexpr int SROWS = 2 * M + NE * 256;
constexpr float EPS = 1e-6f;

constexpr size_t MiB = 1u << 20;
constexpr size_t WS_CTL   = 0;
constexpr size_t CTL_ZERO = 65536;
constexpr size_t WS_STAT  = 1 * MiB;
constexpr size_t ST_VSS = WS_STAT;
constexpr size_t ST_OASS = ST_VSS + (size_t)M * 8 * 4;
constexpr size_t ST_OBSS = ST_OASS + (size_t)M * 16 * 4;
constexpr size_t ST_HSS = ST_OBSS + (size_t)M * 16 * 4;
constexpr size_t ST_FSS = ST_HSS + (size_t)M * 16 * 4;
constexpr size_t ST_R2 = ST_FSS + (size_t)M * 16 * 4;
constexpr size_t ST_R3 = ST_R2 + (size_t)M * 4;
constexpr size_t ST_RE = ST_R3 + (size_t)M * 4;
constexpr size_t ST_RW = ST_RE + (size_t)M * 8;
constexpr size_t ST_SLOT = ST_RW + (size_t)M * 8;
constexpr size_t ST_TOK = ST_SLOT + (size_t)M * 8;
constexpr size_t ST_TW = ST_TOK + (size_t)NE * M * 4;
constexpr size_t ST_TR = ST_TW + (size_t)NE * M * 4;
constexpr size_t ST_AL = ST_TR + (size_t)NE * M * 4;
constexpr size_t ST_END = ST_AL + (size_t)SG * SP * 8;
static_assert(ST_END <= 16 * MiB, "stats region");
constexpr size_t WS_WGU  = 16 * MiB;
constexpr size_t WS_WD   = WS_WGU + 32 * MiB;
constexpr size_t WS_WPG  = WS_WD + 16 * MiB;
constexpr size_t WS_WPP  = WS_WPG + 2 * MiB;
constexpr size_t WS_WIN  = WS_WPP + 1 * MiB;
constexpr size_t WS_WGLU = WS_WIN + 3 * MiB;
constexpr size_t WS_WOUT = WS_WGLU + 1 * MiB;
constexpr size_t WS_WM   = WS_WOUT + 2 * MiB;
constexpr size_t WS_WR   = WS_WM + 256 * 1024;
constexpr size_t WS_A0   = WS_WM + 1 * MiB;
constexpr size_t WS_PP   = WS_A0 + 32 * MiB;
constexpr size_t WS_LATE = WS_PP + 32 * MiB;
constexpr size_t WS_BT1  = WS_LATE;
constexpr size_t WS_BT2  = WS_BT1 + 8 * MiB;
constexpr size_t WS_MIX  = WS_BT2 + 20 * MiB;
constexpr size_t WS_Y2   = WS_MIX + 32 * MiB;
constexpr size_t WS_PB   = WS_Y2 + 16 * MiB;
constexpr size_t WS_XS   = WS_LATE;
constexpr size_t WS_END  = WS_LATE + 84 * MiB;
static_assert(WS_END <= 256 * MiB, "workspace");
constexpr size_t DO_UG = 0;
constexpr size_t DO_VG = 16 * MiB;
constexpr size_t DO_SH = 32 * MiB;
constexpr size_t DO_E  = 52 * MiB;
constexpr size_t DO_HB = 0;
constexpr size_t DO_HH = 32 * MiB;
constexpr int CW_BAR = 0;
constexpr int CW_CNT = 4096;

__device__ __forceinline__ float bf2f(unsigned v) { return __uint_as_float(v << 16); }
__device__ __forceinline__ unsigned f2bf(float f) { unsigned u = __float_as_uint(f); return (u + 0x7fffu + ((u >> 16) & 1u)) >> 16; }
__device__ __forceinline__ unsigned pk2(float lo, float hi) { unsigned r; asm volatile("v_cvt_pk_bf16_f32 %0, %1, %2" : "=v"(r) : "v"(lo), "v"(hi)); return r; }
__device__ __forceinline__ float lo16(unsigned w) { return __uint_as_float(w << 16); }
__device__ __forceinline__ float hi16(unsigned w) { return __uint_as_float(w & 0xffff0000u); }
__device__ __forceinline__ float sigmoidf_(float x) { return __builtin_amdgcn_rcpf(1.0f + __expf(-x)); }
__device__ __forceinline__ float gelu_t(float x) { const float u = x * (1.0f + 0.044715f * x * x); return x * __builtin_amdgcn_rcpf(1.0f + __expf(-1.5957691216057308f * u)); }
__device__ __forceinline__ float wave_sum(float v) {
#pragma unroll
    for (int o = 1; o < 64; o <<= 1) v += __shfl_xor(v, o);
    return v;
}
#define LDS_WAIT() asm volatile("s_waitcnt lgkmcnt(0)" ::: "memory")
#define VM_WAIT() asm volatile("s_waitcnt vmcnt(0)" ::: "memory")

namespace pg8 {
constexpr int BM = 256, BK = 64, HALF = 128, HTB = HALF * BK * 2, STAGE_BYTES = 8 * HTB, NXCD = 8, WGM = 8;
__host__ __device__ __forceinline__ int lds_byte(int r, int c) { const int st = (r >> 4) * 2 + (c >> 5), rr = r & 15, cc = c & 31, ob = rr * 64 + cc * 2; return st * 1024 + (ob ^ (((ob >> 9) & 1) << 5)); }
__host__ __device__ __forceinline__ void stage_rc(int b, int& R, int& C) { const int st = b / 1024, sb = b % 1024, swz = sb ^ (((sb >> 9) & 1) << 5); R = (st >> 1) * 16 + swz / 64; C = (st & 1) * 32 + (swz % 64) / 2; }
__host__ __device__ __forceinline__ int perm32(int rho) { const int n = rho >> 4, i = rho & 15; return 8 * (i >> 2) + 4 * n + (i & 3); }

struct Unit { const char* A; const char* B; int pm, pn, aux; int pos0, nvalid; const int* tok; };
struct Gemm { int lda, ldb, nt; };

struct DenseOrder {
    const char* A; const char* B; size_t tA, tB; int nM, nN, nwg, G, c;
    __device__ void init(const void* A_, int lda, const void* B_, int ldb, int Mr, int Nc, int G_, int c_) { A = (const char*)A_; B = (const char*)B_; tA = (size_t)BM * lda * 2; tB = (size_t)BM * ldb * 2; nM = Mr / BM; nN = Nc / BM; nwg = nM * nN; G = G_; c = c_; }
    __device__ bool next(int i, Unit& u) const {
        const long L = (long)i * G + c; if (L >= nwg) return false;
        int wgid = (int)L; { const int q = nwg / NXCD, r = nwg % NXCD, xcd = wgid % NXCD, off = wgid / NXCD; wgid = (xcd < r ? xcd * (q + 1) : r * (q + 1) + (xcd - r) * q) + off; }
        const int nig = WGM * nN, gid = wgid / nig, fm = gid * WGM, gsz = (nM - fm) < WGM ? (nM - fm) : WGM;
        u.pm = fm + ((wgid % nig) % gsz); u.pn = (wgid % nig) / gsz; u.aux = 0; u.pos0 = 0; u.nvalid = 256; u.tok = nullptr;
        u.A = A + (size_t)u.pm * tA; u.B = B + (size_t)u.pn * tB; return true;
    }
};

template <class Epi, class Sched, bool ALIGN_EPI, bool HOOK, bool GATHER = false>
__device__ __forceinline__ void gemm_phase(LAS unsigned char* lds, const Gemm g, const Sched& S, const Epi& E) {
    const int tid = threadIdx.x, wid = __builtin_amdgcn_readfirstlane(tid >> 6), lane = tid & 63, wr = wid >> 2, wc = wid & 3, fr = lane & 15, fq = lane >> 4;
    int nt_ = g.nt; asm volatile("" : "+s"(nt_)); const int nt = nt_;
    unsigned voffA[2], voffB[2];
#pragma unroll
    for (int i = 0; i < 2; ++i) { int R, C; stage_rc(tid * 16 + i * 8192, R, C); const int Rb = Epi::PERM ? ((R & ~31) + perm32(R & 31)) : R;
        voffA[i] = (unsigned)(R * g.lda + C) * 2u; voffB[i] = (unsigned)(Rb * g.ldb + C) * 2u; }
    unsigned vc[2][2];
    LAS unsigned* vnl = (LAS unsigned*)(lds + 131072 + 4096) + tid;
#define PG8_ROWS(u_, v_) do { _Pragma("unroll") for (int _i = 0; _i < 2; ++_i) { int _R, _C; stage_rc(tid * 16 + _i * 8192, _R, _C); _Pragma("unroll") for (int _h = 0; _h < 2; ++_h) { const int _p = _h * HALF + _R; \
        const int _t = (u_).tok[_p < (u_).nvalid ? _p : 0]; v_[_h][_i] = (unsigned)_t * (unsigned)(g.lda * 2) + (unsigned)_C * 2u; } } } while (0)
#define PG8_STAGE_A(bufoff, kptr, h, usenext) do { if constexpr (GATHER) { _Pragma("unroll") for (int _i = 0; _i < 2; ++_i) \
        __builtin_amdgcn_global_load_lds((const unsigned*)((const char*)(kptr) + ((usenext) ? vnl[((h) * 2 + _i) * 512] : vc[h][_i])), (LAS unsigned*)(lds + (bufoff) + ldsw + _i * 8192), 16, 0, 0); } \
        else { PG8_STAGE(bufoff, (const char*)(kptr) + (h) * hstepA, voffA); } } while (0)
    const size_t kstep = (size_t)(BK * 2);
    const size_t hstepA = (size_t)HALF * g.lda * 2, hstepB = (size_t)HALF * g.ldb * 2;
    const unsigned ldsw = (unsigned)wid * 1024u;
    const int aoff = lds_byte(wr * 64 + fr, fq * 8), boff = lds_byte(wc * 32 + fr, fq * 8);
#define PG8_SA(b, h) (((b) * 2 + (h)) * HTB)
#define PG8_SB(b, h) ((4 + (b) * 2 + (h)) * HTB)
#define PG8_STAGE(bufoff, gbase, voff) do { _Pragma("unroll") for (int _i = 0; _i < 2; ++_i) \
        __builtin_amdgcn_global_load_lds((const unsigned*)((const char*)(gbase) + (voff)[_i]), (LAS unsigned*)(lds + (bufoff) + ldsw + _i * 8192), 16, 0, 0); } while (0)
#define PG8_LDA(dst, b, h) do { _Pragma("unroll") for (int m = 0; m < 4; ++m) _Pragma("unroll") for (int k = 0; k < 2; ++k) dst[m][k] = *(const LAS bf16x8*)(lds + PG8_SA(b, h) + aoff + m * 2048 + k * 1024); } while (0)
#define PG8_LDB(dst, b, h) do { _Pragma("unroll") for (int n = 0; n < 2; ++n) _Pragma("unroll") for (int k = 0; k < 2; ++k) dst[n][k] = *(const LAS bf16x8*)(lds + PG8_SB(b, h) + boff + n * 2048 + k * 1024); } while (0)
#define PG8_MMA(ai, bj, At, Bt) do { __builtin_amdgcn_s_setprio(1); _Pragma("unroll") for (int m = 0; m < 4; ++m) _Pragma("unroll") for (int n = 0; n < 2; ++n) _Pragma("unroll") for (int k = 0; k < 2; ++k) \
        acc[ai][bj][m][n] = __builtin_amdgcn_mfma_f32_16x16x32_bf16(Bt[n][k], At[m][k], acc[ai][bj][m][n], 0, 0, 0); __builtin_amdgcn_s_setprio(0); } while (0)
#define PG8_WAIT_V(n) asm volatile("s_waitcnt vmcnt(" #n ")" ::: "memory")
#define PG8_WAIT_L(n) asm volatile("s_waitcnt lgkmcnt(" #n ")" ::: "memory")
#define PG8_BAR __builtin_amdgcn_s_barrier()
#define PG8_SCHED __builtin_amdgcn_sched_barrier(0)
    Unit cur, nxt; int ui = 0;
    if (!S.next(0, cur)) return;
    f32x4 acc[2][2][4][2];
#pragma unroll
    for (int a = 0; a < 2; ++a)
#pragma unroll
        for (int b = 0; b < 2; ++b)
#pragma unroll
            for (int m = 0; m < 4; ++m)
#pragma unroll
                for (int n = 0; n < 2; ++n) acc[a][b][m][n] = (f32x4){0.f, 0.f, 0.f, 0.f};
    bf16x8 At[4][2], B0[2][2], B1[2][2];
    const char* cA = cur.A; const char* cB = cur.B;
    if constexpr (GATHER) { PG8_ROWS(cur, vc); }
    PG8_STAGE(PG8_SB(0, 0), cB, voffB); PG8_STAGE(PG8_SB(0, 1), cB + hstepB, voffB); PG8_STAGE_A(PG8_SA(0, 0), cA, 0, false); PG8_STAGE_A(PG8_SA(0, 1), cA, 1, false);
    if (wr == 1) PG8_BAR;
    PG8_WAIT_V(2); PG8_BAR;
    PG8_STAGE(PG8_SB(1, 0), cB + kstep, voffB); PG8_STAGE_A(PG8_SA(1, 0), cA + kstep, 0, false); PG8_STAGE(PG8_SB(1, 1), cB + hstepB + kstep, voffB);
    PG8_WAIT_V(6); PG8_BAR;
    for (;;) {
        const bool has_next = S.next(ui + 1, nxt);
        const char* nA = has_next ? nxt.A : cA; const char* nB = has_next ? nxt.B : cB;
        if constexpr (GATHER) { if (has_next) { unsigned vt[2][2]; PG8_ROWS(nxt, vt); _Pragma("unroll") for (int _h = 0; _h < 2; ++_h) _Pragma("unroll") for (int _i = 0; _i < 2; ++_i) vnl[(_h * 2 + _i) * 512] = vt[_h][_i]; } }
        for (int t = 0; t < nt; t += 2) {
            const bool last = (t == nt - 2); const bool un = last && has_next; (void)un;
            if constexpr (HOOK) { if (t == E.hook_t) E.mid(acc, wr, fr); }
            const char* a1 = cA + (size_t)(t + 1) * kstep;
            const char* a2 = last ? nA : cA + (size_t)(t + 2) * kstep; const char* b2 = last ? nB : cB + (size_t)(t + 2) * kstep;
            const char* a3 = a2 + kstep; const char* b3 = b2 + kstep;
            PG8_LDB(B0, 0, 0); PG8_LDB(B1, 0, 1); PG8_SCHED; PG8_LDA(At, 0, 0); PG8_STAGE_A(PG8_SA(1, 1), a1, 1, false);
            PG8_WAIT_V(8); PG8_WAIT_L(0); PG8_BAR; PG8_MMA(0, 0, At, B0); PG8_MMA(0, 1, At, B1); PG8_BAR; PG8_SCHED;
            PG8_LDA(At, 0, 1); PG8_STAGE(PG8_SB(0, 0), b2, voffB); PG8_STAGE(PG8_SB(0, 1), b2 + hstepB, voffB); PG8_STAGE_A(PG8_SA(0, 0), a2, 0, un);
            PG8_WAIT_V(8); PG8_WAIT_L(0); PG8_BAR; PG8_MMA(1, 0, At, B0); PG8_MMA(1, 1, At, B1); PG8_BAR; PG8_SCHED;
            PG8_LDB(B0, 1, 0); PG8_LDB(B1, 1, 1); PG8_SCHED; PG8_LDA(At, 1, 0); PG8_STAGE_A(PG8_SA(0, 1), a2, 1, un);
            PG8_WAIT_V(8); PG8_WAIT_L(0); PG8_BAR; PG8_MMA(0, 0, At, B0); PG8_MMA(0, 1, At, B1); PG8_BAR; PG8_SCHED;
            PG8_LDA(At, 1, 1); PG8_STAGE(PG8_SB(1, 0), b3, voffB); PG8_STAGE(PG8_SB(1, 1), b3 + hstepB, voffB); PG8_STAGE_A(PG8_SA(1, 0), a3, 0, un);
            PG8_WAIT_V(8); PG8_WAIT_L(0); PG8_BAR; PG8_MMA(1, 0, At, B0); PG8_MMA(1, 1, At, B1); PG8_BAR; PG8_SCHED;
        }
        if constexpr (ALIGN_EPI) { if (wr == 0) PG8_BAR; }
        E(acc, cur, wr, wc, fr, fq);
        if (!has_next) break;
#pragma unroll
        for (int a = 0; a < 2; ++a)
#pragma unroll
            for (int b = 0; b < 2; ++b)
#pragma unroll
                for (int m = 0; m < 4; ++m)
#pragma unroll
                    for (int n = 0; n < 2; ++n) acc[a][b][m][n] = (f32x4){0.f, 0.f, 0.f, 0.f};
        cur = nxt; cA = nA; cB = nB; ++ui;
        if constexpr (GATHER) { _Pragma("unroll") for (int _h = 0; _h < 2; ++_h) _Pragma("unroll") for (int _i = 0; _i < 2; ++_i) vc[_h][_i] = vnl[(_h * 2 + _i) * 512]; }
        if constexpr (ALIGN_EPI) { if (wr == 1) PG8_BAR; }
    }
    PG8_WAIT_V(0);
    if constexpr (!ALIGN_EPI) { if (wr == 0) PG8_BAR; }
    PG8_BAR;
#undef PG8_SA
#undef PG8_SB
#undef PG8_STAGE
#undef PG8_STAGE_A
#undef PG8_ROWS
#undef PG8_LDA
#undef PG8_LDB
#undef PG8_MMA
#undef PG8_WAIT_V
#undef PG8_WAIT_L
#undef PG8_BAR
#undef PG8_SCHED
}
}
using pg8::Unit;

#define XB_TMO      128
#define XB_XCNT(j)  (256  + 64 * (j))
#define XB_XSUB(j)  (1280 + 64 * (j))
#define XB_XGEN(j)  (2304 + 64 * (j))
#define XB_TOP      3328
#define XB_TOPGEN   3392
#define XCD_BAR_WORDS 3456
#define XB_SPIN_CAP (1u << 18)
__device__ __forceinline__ unsigned xb_ld(unsigned* p)              { return __hip_atomic_load(p, __ATOMIC_RELAXED, __HIP_MEMORY_SCOPE_AGENT); }
__device__ __forceinline__ unsigned xb_add(unsigned* p, unsigned v) { return __hip_atomic_fetch_add(p, v, __ATOMIC_RELAXED, __HIP_MEMORY_SCOPE_AGENT); }
__device__ __forceinline__ unsigned xb_xcc_id() { return (unsigned)__builtin_amdgcn_s_getreg((3 << 11) | 20) & 0xFu; }
#define XB_SPIN(cond, bar) do { unsigned _sp = 0; while (cond) { __builtin_amdgcn_s_sleep(1); \
    if ((++_sp & 255u) == 0u) { if (xb_ld(&(bar)[XB_TMO])) break; if (_sp > XB_SPIN_CAP) { atomicAdd(&(bar)[XB_TMO], 1u); break; } } } } while (0)
struct XcdBarrier { unsigned* bar; unsigned x; volatile LAS unsigned* st; };
__device__ __forceinline__ XcdBarrier xcd_barrier_post(unsigned* bar, volatile LAS unsigned* st) {
    XcdBarrier b; b.bar = bar; b.x = xb_xcc_id(); b.st = st;
    if (threadIdx.x == 0) (void)xb_add(&bar[XB_XCNT(b.x)], 1u);
    return b;
}
__device__ __forceinline__ void xcd_barrier_complete(unsigned* bar, unsigned x, unsigned& nloc, unsigned& nx) {
    const unsigned G = gridDim.x * gridDim.y * gridDim.z;
    unsigned sum, cnt, mine, sp = 0u;
    for (;;) {
        sum = 0u; cnt = 0u; mine = 0u;
#pragma unroll
        for (unsigned j = 0; j < 16; ++j) { const unsigned c = xb_ld(&bar[XB_XCNT(j)]); sum += c; cnt += (c > 0u) ? 1u : 0u; mine = (j == x) ? c : mine; }
        if (sum == G) break;
        __builtin_amdgcn_s_sleep(1);
        if ((++sp & 255u) == 0u) { if (xb_ld(&bar[XB_TMO])) break; if (sp > XB_SPIN_CAP) { atomicAdd(&bar[XB_TMO], 1u); break; } }
    }
    nloc = mine > 0u ? mine : 1u; nx = cnt > 0u ? cnt : 1u;
}
__device__ __forceinline__ void xcd_barrier(const XcdBarrier& b) {
    asm volatile("s_waitcnt vmcnt(0)" ::: "memory");
    __syncthreads();
    if (threadIdx.x == 0) {
        unsigned* bar = b.bar;
        __builtin_amdgcn_s_waitcnt(0);
        unsigned nloc = b.st[0], nx = b.st[1];
        if (nloc == 0u) { xcd_barrier_complete(bar, b.x, nloc, nx); b.st[0] = nloc; b.st[1] = nx; }
        const unsigned old = xb_add(&bar[XB_XSUB(b.x)], 1u);
        const unsigned gen = old / nloc;
        if (old + 1u == (gen + 1u) * nloc) {
            __builtin_amdgcn_fence(__ATOMIC_RELEASE, "agent");
            asm volatile("s_waitcnt vmcnt(0)" ::: "memory");
            const unsigned og = xb_add(&bar[XB_TOP], 1u);
            const unsigned tg = og / nx;
            if (og + 1u == (tg + 1u) * nx) xb_add(&bar[XB_TOPGEN], 1u);
            else XB_SPIN(xb_ld(&bar[XB_TOPGEN]) == tg, bar);
            __builtin_amdgcn_fence(__ATOMIC_ACQUIRE, "agent");
            xb_add(&bar[XB_XGEN(b.x)], 1u);
            asm volatile("s_waitcnt vmcnt(0)" ::: "memory");
        } else {
            XB_SPIN(xb_ld(&bar[XB_XGEN(b.x)]) == gen, bar);
            __builtin_amdgcn_fence(__ATOMIC_ACQUIRE, "agent");
            asm volatile("s_waitcnt vmcnt(0)" ::: "memory");
        }
    }
    __syncthreads();
}

constexpr int NWAVES = 8, NTHR = 512;
constexpr int RING_BYTES = 131072;
constexpr int AUX_OFF = RING_BYTES;
constexpr int AUX_MISC = AUX_OFF;
constexpr int AUX_RA = AUX_OFF + 256;
constexpr int AUX_RB = AUX_RA + 1024;
constexpr int AUX_TB = AUX_RB + 1024;
constexpr int LDS_BYTES = 147456;

struct Args { const float* in[32]; float* out; unsigned char* ws; int ph_lo, ph_hi; };

struct Frame {
    LAS unsigned char* lds;
    int tid, lane, wave, G, bid;
    unsigned char* ws; unsigned char* dout;
};
#define WSP(T, off) ((T*)(F.ws + (off)))
#define DOP(T, off) ((T*)(F.dout + (off)))

template <class PW, class PS>
__device__ __forceinline__ void transpose_item(PW W, int ldw, int k0, int n0, PS kscale, bool has_scale, bf16_t* WT, int ldt, int dst_row0, LAS unsigned* scr, int lane) {
    const int c4 = lane & 15, rq = lane >> 4;
    f32x4 v[8][2];
#pragma unroll
    for (int i = 0; i < 8; ++i)
#pragma unroll
        for (int h = 0; h < 2; ++h) v[i][h] = *(const f32x4*)(W + (size_t)(k0 + 8 * i + 2 * rq + h) * ldw + n0 + 4 * c4);
    if (has_scale) {
#pragma unroll
        for (int i = 0; i < 8; ++i)
#pragma unroll
            for (int h = 0; h < 2; ++h) v[i][h] = v[i][h] * kscale[k0 + 8 * i + 2 * rq + h];
    }
#pragma unroll
    for (int i = 0; i < 8; ++i)
#pragma unroll
        for (int j = 0; j < 4; ++j) scr[(4 * c4 + j) * 33 + 4 * i + rq] = pk2(v[i][0][j], v[i][1][j]);
    LDS_WAIT(); asm volatile("" ::: "memory");
    const int c = lane & 7;
#pragma unroll
    for (int jj = 0; jj < 8; ++jj) { const int n = (lane >> 3) + 8 * jj; const LAS unsigned* sp = scr + n * 33 + 4 * c;
        u32x4 o; o.x = sp[0]; o.y = sp[1]; o.z = sp[2]; o.w = sp[3];
        *(u32x4*)(WT + (size_t)(dst_row0 + n) * ldt + k0 + 8 * c) = o; }
    LDS_WAIT(); asm volatile("" ::: "memory");
}

template <class AT_> __device__ __forceinline__ void s5_precompute(const AT_& args, Frame& F, int g, int part) {
    LAS float* pwr = (LAS float*)F.lds;
    LAS float* pwi = pwr + 64 * 33;
    LAS float* bbr = pwi + 64 * 33;
    LAS float* bbi = bbr + 64 * 16;
    LAS float* ccr = bbi + 64 * 16;
    LAS float* cci = ccr + 64 * 16;
    LAS float* Kt = cci + 64 * 16;
    const float* a_re = args.in[7]; const float* a_im = args.in[8]; const float* log_dt = args.in[9];
    const float* b_re = args.in[10]; const float* b_im = args.in[11]; const float* c_re = args.in[12]; const float* c_im = args.in[13];
    const int tid = F.tid;
    LAS float* cof = Kt;
    if (tid < 64) {
        const int p = tid;
        const float dt = __expf(log_dt[g]);
        const float lr = a_re[g * SP + p], li = a_im[g * SP + p];
        const float mag = __expf(lr * dt);
        const double ph = (double)li * (double)dt; const double phr = ph - 6.283185307179586 * __builtin_rint(ph * 0.15915494309189535);
        const float sn = sinf((float)phr), cs = cosf((float)phr);
        const float ar = mag * cs, ai = mag * sn;
        const float nr = ar - 1.0f, ni = ai; const float den = lr * lr + li * li;
        cof[p * 2] = (nr * lr + ni * li) / den; cof[p * 2 + 1] = (ni * lr - nr * li) / den;
        double xr = 1.0, xi = 0.0;
        for (int k = 0; k <= 32; ++k) { pwr[p * 33 + k] = (float)xr; pwi[p * 33 + k] = (float)xi; const double t = xr * ar - xi * ai; xi = xr * ai + xi * ar; xr = t; }
        if (part == 0) { float* AL = WSP(float, ST_AL); AL[(g * SP + p) * 2] = pwr[p * 33 + 32]; AL[(g * SP + p) * 2 + 1] = pwi[p * 33 + 32]; }
    }
    __syncthreads();
    for (int i = tid; i < 64 * 16; i += NTHR) { const int p = i >> 4, c = i & 15; const float cr = cof[p * 2], ci = cof[p * 2 + 1];
        const float br = b_re[(g * SP + p) * SC + c], bi = b_im[(g * SP + p) * SC + c]; bbr[i] = cr * br - ci * bi; bbi[i] = cr * bi + ci * br; }
    for (int i = tid; i < 64 * 16; i += NTHR) { const int c = i >> 6, p = i & 63; ccr[p * 16 + c] = c_re[(g * SC + c) * SP + p]; cci[p * 16 + c] = c_im[(g * SC + c) * SP + p]; }
    __syncthreads();
    {
        const int lane = F.lane, co = lane & 15, kq = lane >> 4, h = kq & 1;
        float crv[32], civ[32], bv[32];
#pragma unroll
        for (int st = 0; st < 32; ++st) { const int p = (4 * st + kq) >> 1; crv[st] = ccr[p * 16 + co]; civ[st] = cci[p * 16 + co]; bv[st] = h ? bbi[p * 16 + co] : bbr[p * 16 + co]; }
        for (int kk = 0; kk < 4; ++kk) {
            const int k = F.wave * 4 + kk; f32x4 acc = (f32x4){0.f, 0.f, 0.f, 0.f};
#pragma unroll
            for (int st = 0; st < 32; ++st) {
                const int p = (4 * st + kq) >> 1; const float pr = pwr[p * 33 + k], pi = pwi[p * 33 + k];
                const float a = h ? -(crv[st] * pi + civ[st] * pr) : (crv[st] * pr - civ[st] * pi);
                acc = __builtin_amdgcn_mfma_f32_16x16x4f32(a, bv[st], acc, 0, 0, 0);
            }
#pragma unroll
            for (int r = 0; r < 4; ++r) Kt[(k * 16 + kq * 4 + r) * 16 + co] = acc[r];
        }
    }
    __syncthreads();
    bf16_t* BT2 = WSP(bf16_t, WS_BT2) + (size_t)g * 512 * KS5;
    for (int q = tid; q < 64 * 80; q += NTHR) {
        const int n = part * 64 + q / 80, ch = q % 80, tp = n >> 4, co = n & 15;
        float v[8];
        if (ch < 64) { const int tau = ch >> 1, ci0 = (ch & 1) * 8;
#pragma unroll
            for (int j = 0; j < 8; ++j) v[j] = (tau <= tp) ? Kt[((tp - tau) * 16 + co) * 16 + ci0 + j] : 0.f;
        } else { const int q0 = (ch - 64) * 8;
#pragma unroll
            for (int j = 0; j < 8; ++j) { const int qq = q0 + j, p = qq & 63; const float cr = ccr[p * 16 + co], ci = cci[p * 16 + co], pr = pwr[p * 33 + tp + 1], pi = pwi[p * 33 + tp + 1];
                v[j] = (qq < 64) ? (cr * pr - ci * pi) : -(cr * pi + ci * pr); }
        }
        u32x4 o; o.x = pk2(v[0], v[1]); o.y = pk2(v[2], v[3]); o.z = pk2(v[4], v[5]); o.w = pk2(v[6], v[7]);
        *(u32x4*)(BT2 + (size_t)n * KS5 + ch * 8) = o;
    }
    bf16_t* BT1 = WSP(bf16_t, WS_BT1) + (size_t)g * 256 * 512;
    for (int q = tid; q < 32 * 64; q += NTHR) {
        const int n = part * 32 + q / 64, ch = q % 64, tau = ch >> 1, ci0 = (ch & 1) * 8;
        float v[8];
#pragma unroll
        for (int j = 0; j < 8; ++j) {
            if (n < 128) { const int p = n & 63; const float pr = pwr[p * 33 + 31 - tau], pi = pwi[p * 33 + 31 - tau], br = bbr[p * 16 + ci0 + j], bi = bbi[p * 16 + ci0 + j];
                v[j] = (n < 64) ? (pr * br - pi * bi) : (pr * bi + pi * br); }
            else v[j] = 0.f;
        }
        u32x4 o; o.x = pk2(v[0], v[1]); o.y = pk2(v[2], v[3]); o.z = pk2(v[4], v[5]); o.w = pk2(v[6], v[7]);
        *(u32x4*)(BT1 + (size_t)n * 512 + ch * 8) = o;
    }
    __syncthreads();
}

template <class AT_> __device__ __forceinline__ void expert_items(const AT_& args, Frame& F, int w, int nw) {
    LAS unsigned* scr = (LAS unsigned*)(F.lds + F.wave * 16384);
    constexpr int I_GATE = NE * 64, I_UP = NE * 64, I_DOWN = NE * 64;
    for (int it = w; it < I_GATE + I_UP + I_DOWN; it += nw) {
        int r = it;
        if (r < I_GATE) { const int e = r / 64, q = r % 64, kb = q / 4, nb = q % 4, f0 = nb * 64; const int dst = (f0 >> 7) * 256 + (f0 & 127);
            transpose_item(args.in[25] + (size_t)e * D * FE, FE, kb * 64, f0, args.in[20], true, WSP(bf16_t, WS_WGU) + (size_t)e * 512 * D, D, dst, scr, F.lane); continue; } r -= I_GATE;
        if (r < I_UP) { const int e = r / 64, q = r % 64, kb = q / 4, nb = q % 4, f0 = nb * 64; const int dst = (f0 >> 7) * 256 + 128 + (f0 & 127);
            transpose_item(args.in[26] + (size_t)e * D * FE, FE, kb * 64, f0, args.in[20], true, WSP(bf16_t, WS_WGU) + (size_t)e * 512 * D, D, dst, scr, F.lane); continue; } r -= I_UP;
        { const int e = r / 64, q = r % 64, kb = q / 16, nb = q % 16;
            transpose_item(args.in[27] + (size_t)e * FE * D, D, kb * 64, nb * 64, args.in[27], false, WSP(bf16_t, WS_WD) + (size_t)e * D * FE, FE, nb * 64, scr, F.lane); }
    }
}
template <class AT_> __device__ __forceinline__ void p0_prologue(const AT_& args, Frame& F) {
    LAS unsigned* scr = (LAS unsigned*)(F.lds + F.wave * 16384);
    const int gw = F.bid * NWAVES + F.wave, NGW = F.G * NWAVES;
    constexpr int I_IN = 16 * 24, I_GLU = 8 * 16, I_OUT = 16 * 16, I_PG = 16 * 16, I_PPJ = 4 * 16;
    constexpr int NITEMS = I_IN + I_GLU + I_OUT + I_PG + I_PPJ;
    for (int it = gw; it < NITEMS; it += NGW) {
        int r = it;
        if (r < I_IN) { const int kb = r / 24, nb = r % 24; transpose_item(args.in[3], NPROJ, kb * 64, nb * 64, args.in[3], false, WSP(bf16_t, WS_WIN), D, nb * 64, scr, F.lane); continue; } r -= I_IN;
        if (r < I_GLU) { const int kb = r / 16, nb = r % 16, c0 = nb * 64; const int dst = (c0 < 512) ? ((c0 >> 7) * 256 + (c0 & 127)) : ((((c0 - 512) >> 7)) * 256 + 128 + ((c0 - 512) & 127));
            transpose_item(args.in[15], 2 * WB, kb * 64, c0, args.in[15], false, WSP(bf16_t, WS_WGLU), WB, dst, scr, F.lane); continue; } r -= I_GLU;
        if (r < I_OUT) { const int kb = r / 16, nb = r % 16;
            if (kb < 8) transpose_item(args.in[19], D, kb * 64, nb * 64, args.in[17], true, WSP(bf16_t, WS_WOUT), D, nb * 64, scr, F.lane);
            else transpose_item(args.in[19], D, kb * 64, nb * 64, args.in[18] - 512, true, WSP(bf16_t, WS_WOUT), D, nb * 64, scr, F.lane);
            continue; } r -= I_OUT;
        if (r < I_PG) { const int kb = r / 16, nb = r % 16; transpose_item(args.in[29], D, kb * 64, nb * 64, args.in[28], true, WSP(bf16_t, WS_WPG), D, nb * 64, scr, F.lane); continue; } r -= I_PG;
        { const int kb = r / 16, nb = r % 16; transpose_item(args.in[30], D, kb * 64, nb * 64, args.in[30], false, WSP(bf16_t, WS_WPP), PLE, nb * 64, scr, F.lane); }
    }
    const int gt = F.bid * NTHR + F.tid, NGT = F.G * NTHR;
    { bf16_t* WR = WSP(bf16_t, WS_WR); const float* wc = args.in[21]; const float* wf = args.in[23]; const float* g2 = args.in[20];
      for (int i = gt; i < 64 * D; i += NGT) { const int j = i >> 10, k = i & 1023; float v = 0.f;
          if (j < 4) v = wc[k * 4 + j]; else if (j < 36) { const int gg = (j - 4) >> 3, e = (j - 4) & 7; v = wf[((size_t)gg * D + k) * 8 + e]; }
          WR[i] = (bf16_t)f2bf(v * g2[k]); } }
    { bf16_t* WM = WSP(bf16_t, WS_WM); const float* wsp = args.in[5];
      for (int i = gt; i < HEADS * GCH * GCH; i += NGT) { const int t = (i >> 7) & 127, s = i & 127; WM[i] = (bf16_t)f2bf(s <= t ? wsp[i] : 0.f); } }
    { const f32x4* pp = (const f32x4*)args.in[1]; u32x2* PB = WSP(u32x2, WS_PB);
      for (int i = gt; i < M * PLE / 4; i += NGT) { const f32x4 v = pp[i]; u32x2 o; o.x = pk2(v.x, v.y); o.y = pk2(v.z, v.w); PB[i] = o; } }
    { const float* x = args.in[0]; const float* g1 = args.in[2]; bf16_t* XN = WSP(bf16_t, WS_A0);
      f32x4 gv[4];
#pragma unroll
      for (int j = 0; j < 4; ++j) gv[j] = ((const f32x4*)g1)[F.lane + 64 * j];
      for (int rp = 0; rp < (SUBREP == 3 ? 2 : 1); ++rp)
      for (int m = gw; m < M; m += NGW) {
          const f32x4* xr = (const f32x4*)(x + (size_t)m * D) + F.lane; f32x4 v[4]; float s = 0.f;
#pragma unroll
          for (int j = 0; j < 4; ++j) { v[j] = xr[64 * j]; s += (v[j].x * v[j].x + v[j].y * v[j].y) + (v[j].z * v[j].z + v[j].w * v[j].w); }
          const float r = rsqrtf(wave_sum(s) * (1.f / D) + EPS);
          u32x2* o8 = (u32x2*)(XN + (size_t)m * D) + F.lane;
#pragma unroll
          for (int j = 0; j < 4; ++j) { u32x2 o; o.x = pk2(v[j].x * r * gv[j].x, v[j].y * r * gv[j].y); o.y = pk2(v[j].z * r * gv[j].z, v[j].w * r * gv[j].w); o8[64 * j] = o; }
      } }
}

typedef f32x4 AccT[2][2][4][2];
struct EpiProj {
    static constexpr bool PERM = true; static constexpr int hook_t = -1;
    bf16_t* UG; bf16_t* VG; bf16_t* SH; float* VSS;
    __device__ __forceinline__ void mid(AccT&, int, int) const {}
    __device__ __forceinline__ void operator()(const AccT& acc, const Unit& u, int wr, int wc, int fr, int fq) const {
        const int kind = u.pn >> 1, cb = (u.pn & 1) * 256;
#pragma unroll
        for (int ai = 0; ai < 2; ++ai)
#pragma unroll
            for (int m = 0; m < 4; ++m) {
                const int row = u.pm * 256 + ai * 128 + wr * 64 + m * 16 + fr; float ss = 0.f;
#pragma unroll
                for (int bj = 0; bj < 2; ++bj) {
                    const int col = cb + bj * 128 + wc * 32 + fq * 8; f32x4 v0 = acc[ai][bj][m][0], v1 = acc[ai][bj][m][1];
                    if (kind < 2) {
                        v0 = (f32x4){gelu_t(v0[0]), gelu_t(v0[1]), gelu_t(v0[2]), gelu_t(v0[3])}; v1 = (f32x4){gelu_t(v1[0]), gelu_t(v1[1]), gelu_t(v1[2]), gelu_t(v1[3])};
                        ss += (v0[0] * v0[0] + v0[1] * v0[1]) + (v0[2] * v0[2] + v0[3] * v0[3]) + (v1[0] * v1[0] + v1[1] * v1[1]) + (v1[2] * v1[2] + v1[3] * v1[3]);
                    }
                    u32x4 w; w.x = pk2(v0[0], v0[1]); w.y = pk2(v0[2], v0[3]); w.z = pk2(v1[0], v1[1]); w.w = pk2(v1[2], v1[3]);
                    if (kind == 0) *(u32x4*)(UG + (size_t)row * WA + col) = w;
                    else if (kind == 1) *(u32x4*)(VG + (size_t)row * WA + col) = w;
                    else { const int g = col >> 4, ci0 = col & 15; *(u32x4*)(SH + ((size_t)(g * NCHK + (row >> 5)) * KS5 + (row & 31) * 16 + ci0)) = w; }
                }
                if (kind == 1) { ss += __shfl_xor(ss, 16); ss += __shfl_xor(ss, 32); if (fq == 0) VSS[row * 8 + (u.pn & 1) * 4 + wc] = ss; }
            }
    }
};
struct EpiS5a {
    static constexpr bool PERM = false; static constexpr int hook_t = -1;
    float* E;
    __device__ __forceinline__ void mid(AccT&, int, int) const {}
    __device__ __forceinline__ void operator()(const AccT& acc, const Unit& u, int wr, int wc, int fr, int fq) const {
#pragma unroll
        for (int ai = 0; ai < 2; ++ai)
#pragma unroll
            for (int m = 0; m < 4; ++m) { const int r = u.pm * 256 + ai * 128 + wr * 64 + m * 16 + fr; float* rowp = E + ((size_t)u.aux * NCHK + r) * 128 + wc * 32 + fq * 4;
#pragma unroll
                for (int n = 0; n < 2; ++n) *(f32x4*)(rowp + n * 16) = acc[ai][0][m][n]; }
    }
};
struct EpiS5b {
    static constexpr bool PERM = true; static constexpr int hook_t = -1;
    const bf16_t* SH; const float* dskip; bf16_t* Y2;
    __device__ __forceinline__ void mid(AccT&, int, int) const {}
    __device__ __forceinline__ void operator()(const AccT& acc, const Unit& u, int wr, int wc, int fr, int fq) const {
        const int g = u.aux;
#pragma unroll
        for (int bj = 0; bj < 2; ++bj) {
            const int n = u.pn * 256 + bj * 128 + wc * 32 + fq * 8, tp = n >> 4, co0 = n & 15;
            const f32x4 d0 = *(const f32x4*)(dskip + g * 16 + co0), d1 = *(const f32x4*)(dskip + g * 16 + co0 + 4);
#pragma unroll
            for (int ai = 0; ai < 2; ++ai)
#pragma unroll
                for (int m = 0; m < 4; ++m) {
                    const int r = u.pm * 256 + ai * 128 + wr * 64 + m * 16 + fr;
                    const u32x4 sv = *(const u32x4*)(SH + ((size_t)(g * NCHK + r) * KS5 + n));
                    const f32x4 v0 = acc[ai][bj][m][0], v1 = acc[ai][bj][m][1];
                    u32x4 w;
                    w.x = pk2(gelu_t(v0[0] + d0[0] * lo16(sv.x)), gelu_t(v0[1] + d0[1] * hi16(sv.x)));
                    w.y = pk2(gelu_t(v0[2] + d0[2] * lo16(sv.y)), gelu_t(v0[3] + d0[3] * hi16(sv.y)));
                    w.z = pk2(gelu_t(v1[0] + d1[0] * lo16(sv.z)), gelu_t(v1[1] + d1[1] * hi16(sv.z)));
                    w.w = pk2(gelu_t(v1[2] + d1[2] * lo16(sv.w)), gelu_t(v1[3] + d1[3] * hi16(sv.w)));
                    *(u32x4*)(Y2 + ((size_t)(r * SL + tp) * WB + g * 16 + co0)) = w;
                }
        }
    }
};
struct EpiGlu {
    static constexpr bool PERM = true; static constexpr int hook_t = -1;
    const float* bglu; bf16_t* MIX; float* OBSS;
    __device__ __forceinline__ void mid(AccT&, int, int) const {}
    __device__ __forceinline__ void operator()(const AccT& acc, const Unit& u, int wr, int wc, int fr, int fq) const {
        const int col = u.pn * 128 + wc * 32 + fq * 8;
        const f32x4 bv0 = *(const f32x4*)(bglu + col), bv1 = *(const f32x4*)(bglu + col + 4), bg0 = *(const f32x4*)(bglu + 512 + col), bg1 = *(const f32x4*)(bglu + 512 + col + 4);
#pragma unroll
        for (int ai = 0; ai < 2; ++ai)
#pragma unroll
            for (int m = 0; m < 4; ++m) {
                const int row = u.pm * 256 + ai * 128 + wr * 64 + m * 16 + fr;
                const f32x4 a0 = acc[ai][0][m][0] + bv0, a1 = acc[ai][0][m][1] + bv1, g0 = acc[ai][1][m][0] + bg0, g1 = acc[ai][1][m][1] + bg1;
                float o[8];
#pragma unroll
                for (int j = 0; j < 4; ++j) { o[j] = a0[j] * sigmoidf_(g0[j]); o[4 + j] = a1[j] * sigmoidf_(g1[j]); }
                float ss = 0.f;
#pragma unroll
                for (int j = 0; j < 8; ++j) ss += o[j] * o[j];
                u32x4 w; w.x = pk2(o[0], o[1]); w.y = pk2(o[2], o[3]); w.z = pk2(o[4], o[5]); w.w = pk2(o[6], o[7]);
                *(u32x4*)(MIX + (size_t)row * D + 512 + col) = w;
                ss += __shfl_xor(ss, 16); ss += __shfl_xor(ss, 32); if (fq == 0) OBSS[row * 16 + u.pn * 4 + wc] = ss;
            }
    }
};
struct EpiOut {
    static constexpr bool PERM = true; static constexpr int hook_t = 8;
    const float* x; bf16_t* HB; float* HSS; const LAS float* ra; const LAS float* rb;
    __device__ __forceinline__ void mid(AccT& acc, int wr, int fr) const {
#pragma unroll
        for (int ai = 0; ai < 2; ++ai)
#pragma unroll
            for (int m = 0; m < 4; ++m) { const int rl = ai * 128 + wr * 64 + m * 16 + fr; const float f = ra[rl] / rb[rl];
#pragma unroll
                for (int bj = 0; bj < 2; ++bj)
#pragma unroll
                    for (int n = 0; n < 2; ++n) acc[ai][bj][m][n] = acc[ai][bj][m][n] * f; }
    }
    __device__ __forceinline__ void operator()(const AccT& acc, const Unit& u, int wr, int wc, int fr, int fq) const {
#pragma unroll
        for (int ai = 0; ai < 2; ++ai)
#pragma unroll
            for (int m = 0; m < 4; ++m) {
                const int rl = ai * 128 + wr * 64 + m * 16 + fr, row = u.pm * 256 + rl; const float f = rb[rl]; float ss = 0.f;
#pragma unroll
                for (int bj = 0; bj < 2; ++bj) {
                    const int col = u.pn * 256 + bj * 128 + wc * 32 + fq * 8;
                    const f32x4 x0 = *(const f32x4*)(x + (size_t)row * D + col), x1 = *(const f32x4*)(x + (size_t)row * D + col + 4);
                    const f32x4 h0 = x0 + acc[ai][bj][m][0] * f, h1 = x1 + acc[ai][bj][m][1] * f;
                    ss += (h0[0] * h0[0] + h0[1] * h0[1]) + (h0[2] * h0[2] + h0[3] * h0[3]) + (h1[0] * h1[0] + h1[1] * h1[1]) + (h1[2] * h1[2] + h1[3] * h1[3]);
                    u32x4 w; w.x = pk2(h0[0], h0[1]); w.y = pk2(h0[2], h0[3]); w.z = pk2(h1[0], h1[1]); w.w = pk2(h1[2], h1[3]);
                    *(u32x4*)(HB + (size_t)row * D + col) = w;
                }
                ss += __shfl_xor(ss, 16); ss += __shfl_xor(ss, 32); if (fq == 0) HSS[row * 16 + u.pn * 4 + wc] = ss;
            }
    }
};
struct EpiBf {
    static constexpr bool PERM = true; static constexpr int hook_t = -1;
    bf16_t* O; int ldc;
    __device__ __forceinline__ void mid(AccT&, int, int) const {}
    __device__ __forceinline__ void operator()(const AccT& acc, const Unit& u, int wr, int wc, int fr, int fq) const {
#pragma unroll
        for (int ai = 0; ai < 2; ++ai)
#pragma unroll
            for (int m = 0; m < 4; ++m) { const int row = u.pm * 256 + ai * 128 + wr * 64 + m * 16 + fr;
#pragma unroll
                for (int bj = 0; bj < 2; ++bj) { const int col = u.pn * 256 + bj * 128 + wc * 32 + fq * 8; const f32x4 v0 = acc[ai][bj][m][0], v1 = acc[ai][bj][m][1];
                    u32x4 w; w.x = pk2(v0[0], v0[1]); w.y = pk2(v0[2], v0[3]); w.z = pk2(v1[0], v1[1]); w.w = pk2(v1[2], v1[3]);
                    *(u32x4*)(O + (size_t)row * ldc + col) = w; } }
    }
};
struct EpiGU {
    static constexpr bool PERM = true; static constexpr int hook_t = -1;
    const float* TR; bf16_t* HH;
    __device__ __forceinline__ void mid(AccT&, int, int) const {}
    __device__ __forceinline__ void operator()(const AccT& acc, const Unit& u, int wr, int wc, int fr, int fq) const {
        const int col = u.pn * 128 + wc * 32 + fq * 8; const float* tr = TR + (size_t)u.aux * M + u.pos0;
#pragma unroll
        for (int ai = 0; ai < 2; ++ai)
#pragma unroll
            for (int m = 0; m < 4; ++m) { const int rl = ai * 128 + wr * 64 + m * 16 + fr; const int row = u.pm * 256 + rl;
                if (rl < u.nvalid) { const float r2 = tr[rl];
                const f32x4 g0 = acc[ai][0][m][0] * r2, g1 = acc[ai][0][m][1] * r2, u0 = acc[ai][1][m][0] * r2, u1 = acc[ai][1][m][1] * r2;
                float o[8];
#pragma unroll
                for (int j = 0; j < 4; ++j) { o[j] = g0[j] * sigmoidf_(g0[j]) * u0[j]; o[4 + j] = g1[j] * sigmoidf_(g1[j]) * u1[j]; }
                u32x4 w; w.x = pk2(o[0], o[1]); w.y = pk2(o[2], o[3]); w.z = pk2(o[4], o[5]); w.w = pk2(o[6], o[7]);
                *(u32x4*)(HH + (size_t)row * FE + col) = w; } }
    }
};
struct EpiDown {
    static constexpr bool PERM = true; static constexpr int hook_t = -1;
    const float* TW; bf16_t* YE;
    __device__ __forceinline__ void mid(AccT&, int, int) const {}
    __device__ __forceinline__ void operator()(const AccT& acc, const Unit& u, int wr, int wc, int fr, int fq) const {
        const float* tw = TW + (size_t)u.aux * M + u.pos0;
#pragma unroll
        for (int ai = 0; ai < 2; ++ai)
#pragma unroll
            for (int m = 0; m < 4; ++m) { const int rl = ai * 128 + wr * 64 + m * 16 + fr; const int row = u.pm * 256 + rl;
                if (rl < u.nvalid) { const float wgt = tw[rl];
#pragma unroll
                for (int bj = 0; bj < 2; ++bj) { const int col = u.pn * 256 + bj * 128 + wc * 32 + fq * 8; const f32x4 v0 = acc[ai][bj][m][0] * wgt, v1 = acc[ai][bj][m][1] * wgt;
                    u32x4 w; w.x = pk2(v0[0], v0[1]); w.y = pk2(v0[2], v0[3]); w.z = pk2(v1[0], v1[1]); w.w = pk2(v1[2], v1[3]);
                    *(u32x4*)(YE + (size_t)row * D + col) = w; } } }
    }
};
struct EpiPle {
    static constexpr bool PERM = false; static constexpr int hook_t = -1;
    const bf16_t* H2B; const bf16_t* PP; const float* R3; float* out; float* FSS;
    __device__ __forceinline__ void mid(AccT&, int, int) const {}
    __device__ __forceinline__ void operator()(const AccT& acc, const Unit& u, int wr, int wc, int fr, int fq) const {
#pragma unroll
        for (int ai = 0; ai < 2; ++ai)
#pragma unroll
            for (int m = 0; m < 4; ++m) { const int row = u.pm * 256 + ai * 128 + wr * 64 + m * 16 + fr; const float r3 = R3[row]; float ss = 0.f;
#pragma unroll
                for (int bj = 0; bj < 2; ++bj)
#pragma unroll
                    for (int n = 0; n < 2; ++n) { const int col = u.pn * 256 + bj * 128 + wc * 32 + n * 16 + fq * 4; const size_t off = (size_t)row * D + col;
                        const u32x2 hv = *(const u32x2*)(H2B + off), pv = *(const u32x2*)(PP + off); const f32x4 a = acc[ai][bj][m][n];
                        f32x4 o; o[0] = lo16(hv.x) + sigmoidf_(a[0] * r3) * lo16(pv.x); o[1] = hi16(hv.x) + sigmoidf_(a[1] * r3) * hi16(pv.x);
                        o[2] = lo16(hv.y) + sigmoidf_(a[2] * r3) * lo16(pv.y); o[3] = hi16(hv.y) + sigmoidf_(a[3] * r3) * hi16(pv.y);
                        ss += (o[0] * o[0] + o[1] * o[1]) + (o[2] * o[2] + o[3] * o[3]);
                        *(f32x4*)(out + off) = o; }
                ss += __shfl_xor(ss, 16); ss += __shfl_xor(ss, 32); if (fq == 0) FSS[row * 16 + u.pn * 4 + wc] = ss; }
    }
};

struct S5Order {
    const char* SH; const char* BT; int npn, nrowsB, ldb, G, c;
    __device__ bool next(int i, Unit& u) const {
        const int L = i * G + c; if (L >= SG * npn * 2) return false;
        const int g = L / (npn * 2), rem = L % (npn * 2); u.pn = rem >> 1; u.pm = rem & 1; u.aux = g; u.pos0 = 0; u.nvalid = 256; u.tok = nullptr;
        u.A = SH + (size_t)(g * NCHK + u.pm * 256) * KS5 * 2; u.B = BT + (size_t)(g * nrowsB + u.pn * 256) * ldb * 2; return true;
    }
};
struct OneUnit { Unit u; __device__ bool next(int i, Unit& o) const { if (i) return false; o = u; return true; } };
struct MoeOrder {
    const char* Abase; size_t tA; const char* Bbase; size_t eB, tB; const LAS int* tb; const int* TOK; int npn, G, c;
    __device__ bool next(int i, Unit& u) const {
        const int L = i * G + c; const int ntile = __builtin_amdgcn_readfirstlane(tb[NE]);
        if (L >= ntile * npn) return false;
        const int tile = L / npn; u.pn = L % npn; u.pm = tile; int e = 0;
        for (int j = 1; j < NE; ++j) e += (__builtin_amdgcn_readfirstlane(tb[j]) <= tile) ? 1 : 0;
        const int t0 = __builtin_amdgcn_readfirstlane(tb[e]), ne = __builtin_amdgcn_readfirstlane(tb[40 + e]);
        u.aux = e; u.pos0 = (tile - t0) * 256; u.nvalid = ne - u.pos0; u.tok = TOK + (size_t)e * M + u.pos0;
        u.A = Abase + (size_t)tile * tA; u.B = Bbase + (size_t)e * eB + (size_t)u.pn * tB; return true;
    }
};

template <class AT_> __device__ __forceinline__ void gmlp_unit(const AT_& args, Frame& F, int c, int h) {
    LAS bf16_t* vnT = (LAS bf16_t*)F.lds;
    LAS float* rv = (LAS float*)(F.lds + 64 * 136 * 2);
    const bf16_t* VG = DOP(bf16_t, DO_VG); const bf16_t* UG = DOP(bf16_t, DO_UG); const float* VSS = WSP(float, ST_VSS);
    const bf16_t* WM = WSP(bf16_t, WS_WM); bf16_t* MIX = WSP(bf16_t, WS_MIX); float* OASS = WSP(float, ST_OASS);
    const float* sgu = args.in[4]; const float* bsp = args.in[6];
    const int tid = F.tid, row0 = c * GCH;
    if (tid < 128) { const f32x4* p = (const f32x4*)(VSS + (size_t)(row0 + tid) * 8); const f32x4 a = p[0], b = p[1];
        rv[tid] = rsqrtf(((a[0] + a[1]) + (a[2] + a[3]) + (b[0] + b[1]) + (b[2] + b[3])) * (1.f / WA) + EPS); }
    __syncthreads();
    {
        const int s = tid >> 2, dq = (tid & 3) * 16; const float r = rv[s];
        const u32x4 a = *(const u32x4*)(VG + (size_t)(row0 + s) * WA + h * DH + dq), b = *(const u32x4*)(VG + (size_t)(row0 + s) * WA + h * DH + dq + 8);
        const unsigned w[8] = {a.x, a.y, a.z, a.w, b.x, b.y, b.z, b.w};
#pragma unroll
        for (int j = 0; j < 8; ++j) { const int d = dq + 2 * j; const float g0 = sgu[h * DH + d], g1 = sgu[h * DH + d + 1];
            vnT[d * 136 + s] = (bf16_t)f2bf(lo16(w[j]) * r * g0); vnT[(d + 1) * 136 + s] = (bf16_t)f2bf(hi16(w[j]) * r * g1); }
    }
    __syncthreads();
    const int wv = F.wave, lane = F.lane, dtile = wv & 1, ttile = wv >> 1, r = lane & 31, hh = lane >> 5;
    f32x16 acc;
#pragma unroll
    for (int i = 0; i < 16; ++i) acc[i] = 0.f;
    const int nks = 2 * (ttile + 1);
    const bf16_t* wrow = WM + ((size_t)(h * GCH + ttile * 32 + r) * GCH + 8 * hh);
    const LAS bf16_t* arow = vnT + (dtile * 32 + r) * 136 + 8 * hh;
    for (int ks = 0; ks < nks; ++ks) {
        const bf16x8 a = *(const LAS bf16x8*)(arow + ks * 16);
        const bf16x8 b = *(const bf16x8*)(wrow + ks * 16);
        acc = __builtin_amdgcn_mfma_f32_32x32x16_bf16(a, b, acc, 0, 0, 0);
    }
    const int t = ttile * 32 + r, row = row0 + t; const float bias = bsp[h * GCH + t]; float ss = 0.f;
#pragma unroll
    for (int gq = 0; gq < 4; ++gq) {
        const int d0 = dtile * 32 + 8 * gq + 4 * hh; const size_t uoff = (size_t)row * WA + h * DH + d0;
        const u32x2 uv = *(const u32x2*)(UG + uoff);
        const float o0 = lo16(uv.x) * (acc[4 * gq + 0] + bias), o1 = hi16(uv.x) * (acc[4 * gq + 1] + bias), o2 = lo16(uv.y) * (acc[4 * gq + 2] + bias), o3 = hi16(uv.y) * (acc[4 * gq + 3] + bias);
        ss += (o0 * o0 + o1 * o1) + (o2 * o2 + o3 * o3);
        u32x2 w; w.x = pk2(o0, o1); w.y = pk2(o2, o3);
        *(u32x2*)(MIX + (size_t)row * D + h * DH + d0) = w;
    }
    ss += __shfl_xor(ss, 32);
    if (hh == 0) OASS[row * 16 + h * 2 + dtile] = ss;
    __syncthreads();
}

__device__ __forceinline__ void s5_scan(Frame& F) {
    const int idx = F.bid * NTHR + F.tid; if (idx >= 4 * SG * SP) return;
    const int p = idx & 63, g = (idx >> 6) & 31, b = idx >> 11;
    const float* AL = WSP(float, ST_AL); const float ar = AL[(g * SP + p) * 2], ai = AL[(g * SP + p) * 2 + 1];
    const float* E = DOP(float, DO_E) + ((size_t)g * NCHK + b * CPB) * 128;
    bf16_t* SH = DOP(bf16_t, DO_SH) + ((size_t)g * NCHK + b * CPB) * KS5 + 512;
    float hr = 0.f, hi = 0.f;
    for (int j0 = 0; j0 < CPB; j0 += 8) {
        float er[8], ei[8];
#pragma unroll
        for (int j = 0; j < 8; ++j) { er[j] = E[(size_t)(j0 + j) * 128 + p]; ei[j] = E[(size_t)(j0 + j) * 128 + 64 + p]; }
#pragma unroll
        for (int j = 0; j < 8; ++j) {
            SH[(size_t)(j0 + j) * KS5 + p] = (bf16_t)f2bf(hr); SH[(size_t)(j0 + j) * KS5 + 64 + p] = (bf16_t)f2bf(hi);
            const float nr = ar * hr - ai * hi + er[j]; hi = ar * hi + ai * hr + ei[j]; hr = nr;
        }
    }
}

template <class AT_> __device__ __forceinline__ void router_phase(const AT_& args, Frame& F, unsigned* CNT) {
    constexpr int WRS = 1032;
    LAS bf16_t* WrL = (LAS bf16_t*)F.lds;
    LAS float* LG = (LAS float*)(F.lds + 48 * WRS * 2);
    LAS int* hist = (LAS int*)(F.lds + 48 * WRS * 2 + 2 * 64 * 48 * 4);
    const bf16_t* WR = WSP(bf16_t, WS_WR); const bf16_t* HB = DOP(bf16_t, DO_HB); const float* HSS = WSP(float, ST_HSS);
    const float* bc = args.in[22]; const float* bfine = args.in[24];
    int* RE = WSP(int, ST_RE); int* RP = WSP(int, ST_SLOT); int* TOK = WSP(int, ST_TOK); float* TW = WSP(float, ST_TW); float* TR = WSP(float, ST_TR);
    const int tid = F.tid, lane = F.lane, wv = F.wave;
    for (int i = tid; i < 48 * 128; i += NTHR) { const int rr = i >> 7, ch = i & 127; *(LAS u32x4*)(WrL + rr * WRS + ch * 8) = *(const u32x4*)(WR + (size_t)rr * D + ch * 8); }
    __syncthreads();
    const int mt = wv & 3, kh = wv >> 2, fr = lane & 15, fq = lane >> 4;
    for (int unit = F.bid; unit < M / 64; unit += F.G) {
        const int row0 = unit * 64;
        if (tid < 64) hist[tid] = 0;
        f32x4 acc[3];
#pragma unroll
        for (int n = 0; n < 3; ++n) acc[n] = (f32x4){0.f, 0.f, 0.f, 0.f};
        const bf16_t* arow = HB + (size_t)(row0 + mt * 16 + fr) * D + kh * 512 + fq * 8;
#pragma unroll 4
        for (int ks = 0; ks < 16; ++ks) {
            const bf16x8 a = *(const bf16x8*)(arow + ks * 32);
#pragma unroll
            for (int n = 0; n < 3; ++n) { const bf16x8 b = *(const LAS bf16x8*)(WrL + (n * 16 + fr) * WRS + kh * 512 + ks * 32 + fq * 8);
                acc[n] = __builtin_amdgcn_mfma_f32_16x16x32_bf16(a, b, acc[n], 0, 0, 0); }
        }
#pragma unroll
        for (int n = 0; n < 3; ++n)
#pragma unroll
            for (int j = 0; j < 4; ++j) LG[(kh * 64 + mt * 16 + fq * 4 + j) * 48 + n * 16 + fr] = acc[n][j];
        __syncthreads();
        int e1 = 0, e2 = 0, l1 = 0, l2 = 0; float w1 = 0.f, w2 = 0.f, r2 = 0.f; const int row = row0 + tid;
        if (tid < 64) {
            const f32x4* hp = (const f32x4*)(HSS + (size_t)row * 16); const f32x4 s0 = hp[0], s1 = hp[1], s2 = hp[2], s3 = hp[3];
            const float ssum = ((s0[0] + s0[1]) + (s0[2] + s0[3])) + ((s1[0] + s1[1]) + (s1[2] + s1[3])) + ((s2[0] + s2[1]) + (s2[2] + s2[3])) + ((s3[0] + s3[1]) + (s3[2] + s3[3]));
            r2 = rsqrtf(ssum * (1.f / D) + EPS);
            const LAS float* lg0 = LG + tid * 48; const LAS float* lg1 = LG + (64 + tid) * 48;
            float lc[4]; int gs = 0; float lmax;
#pragma unroll
            for (int j = 0; j < 4; ++j) lc[j] = (lg0[j] + lg1[j]) * r2 + bc[j];
            lmax = lc[0];
#pragma unroll
            for (int j = 1; j < 4; ++j) if (lc[j] > lmax) { lmax = lc[j]; gs = j; }
            float den = 0.f;
#pragma unroll
            for (int j = 0; j < 4; ++j) den += __expf(lc[j] - lmax);
            const float pg = 1.0f / den;
            float lf[8];
#pragma unroll
            for (int j = 0; j < 8; ++j) lf[j] = (lg0[4 + gs * 8 + j] + lg1[4 + gs * 8 + j]) * r2 + bfine[gs * 8 + j];
            int i1 = 0; float m1 = lf[0];
#pragma unroll
            for (int j = 1; j < 8; ++j) if (lf[j] > m1) { m1 = lf[j]; i1 = j; }
            int i2 = -1; float m2 = -3.0e38f;
#pragma unroll
            for (int j = 0; j < 8; ++j) if (j != i1 && lf[j] > m2) { m2 = lf[j]; i2 = j; }
            const float q2 = __expf(m2 - m1); const float inv = pg / (1.0f + q2);
            w1 = inv; w2 = q2 * inv; e1 = gs * 8 + i1; e2 = gs * 8 + i2;
            l1 = atomicAdd((int*)&hist[e1], 1); l2 = atomicAdd((int*)&hist[e2], 1);
        }
        __syncthreads();
        if (tid < 32) hist[32 + tid] = (int)atomicAdd(&CNT[tid], (unsigned)hist[tid]);
        __syncthreads();
        if (tid < 64) {
            const int p1 = hist[32 + e1] + l1, p2 = hist[32 + e2] + l2;
            TOK[(size_t)e1 * M + p1] = row; TOK[(size_t)e2 * M + p2] = row; TW[(size_t)e1 * M + p1] = w1; TW[(size_t)e2 * M + p2] = w2; TR[(size_t)e1 * M + p1] = r2; TR[(size_t)e2 * M + p2] = r2;
            RE[row * 2] = e1; RE[row * 2 + 1] = e2; RP[row * 2] = p1; RP[row * 2 + 1] = p2;
        }
        __syncthreads();
    }
}

__device__ __forceinline__ void moe_tiles(Frame& F, const unsigned* CNT) {
    LAS int* tb = (LAS int*)(F.lds + AUX_TB);
    if (F.tid == 0) { int t = 0; for (int e = 0; e < NE; ++e) { const int n = (int)__hip_atomic_load(CNT + e, __ATOMIC_RELAXED, __HIP_MEMORY_SCOPE_AGENT); tb[e] = t; tb[40 + e] = n; t += (n + 255) >> 8; } tb[NE] = t; }
    __syncthreads();
}

constexpr int NPHASE = 12;
template <int K, class AT_> __device__ __forceinline__ void phase_body(const AT_& args, Frame& F) {
    LAS unsigned char* ring = F.lds; const int c = F.bid; unsigned* CNT = (unsigned*)(F.ws + WS_CTL) + CW_CNT; (void)ring; (void)c; (void)CNT;
    if constexpr (K == 0) { p0_prologue(args, F);
    }
    if constexpr (K == 1) {
        pg8::DenseOrder S; S.init(WSP(bf16_t, WS_A0), D, WSP(bf16_t, WS_WIN), D, M, NPROJ, F.G, c);
        EpiProj E{DOP(bf16_t, DO_UG), DOP(bf16_t, DO_VG), DOP(bf16_t, DO_SH), WSP(float, ST_VSS)};
        pg8::gemm_phase<EpiProj, pg8::DenseOrder, true, false>(ring, pg8::Gemm{D, D, 16}, S, E);
        { const int nidle = F.G - 128; if (nidle > 0) { if (c >= 128) for (int u = c - 128; u < SG * 8; u += nidle) s5_precompute(args, F, u >> 3, u & 7); }
          else for (int u = c; u < SG * 8; u += F.G) s5_precompute(args, F, u >> 3, u & 7); }
    }
    if constexpr (K == 2) {
        for (int u = F.bid; u < (M / GCH) * HEADS; u += F.G) gmlp_unit(args, F, u >> 3, u & 7);
        S5Order S{(const char*)DOP(bf16_t, DO_SH), (const char*)WSP(bf16_t, WS_BT1), 1, 256, 512, F.G, c};
        EpiS5a E{DOP(float, DO_E)};
        pg8::gemm_phase<EpiS5a, S5Order, true, false>(ring, pg8::Gemm{KS5, 512, 8}, S, E);
    }
    if constexpr (K == 3) {
        s5_scan(F);
    }
    if constexpr (K == 4) {
        S5Order S{(const char*)DOP(bf16_t, DO_SH), (const char*)WSP(bf16_t, WS_BT2), 2, 512, KS5, F.G, c};
        EpiS5b E{DOP(bf16_t, DO_SH), args.in[14], WSP(bf16_t, WS_Y2)};
        pg8::gemm_phase<EpiS5b, S5Order, true, false>(ring, pg8::Gemm{KS5, KS5, 10}, S, E);
        { const int nidle = F.G - 128; if (nidle > 0) { if (c >= 128) expert_items(args, F, (c - 128) * NWAVES + F.wave, nidle * NWAVES); }
          else expert_items(args, F, c * NWAVES + F.wave, F.G * NWAVES); }
    }
    if constexpr (K == 5) {
        pg8::DenseOrder S; S.init(WSP(bf16_t, WS_Y2), WB, WSP(bf16_t, WS_WGLU), WB, M, 2 * WB, F.G, c);
        EpiGlu E{args.in[16], WSP(bf16_t, WS_MIX), WSP(float, ST_OBSS)};
        pg8::gemm_phase<EpiGlu, pg8::DenseOrder, true, false>(ring, pg8::Gemm{WB, WB, 8}, S, E);
    }
    if constexpr (K == 6) {
        pg8::DenseOrder S; S.init(WSP(bf16_t, WS_MIX), D, WSP(bf16_t, WS_WOUT), D, M, D, F.G, c);
        LAS float* ra = (LAS float*)(F.lds + AUX_RA); LAS float* rb = (LAS float*)(F.lds + AUX_RB);
        EpiOut E{args.in[0], DOP(bf16_t, DO_HB), WSP(float, ST_HSS), ra, rb};
        for (int i = 0;; ++i) {
            Unit u; if (!S.next(i, u)) break;
            __syncthreads();
            if (F.tid < 256) { const int row = u.pm * 256 + F.tid; const f32x4* pa = (const f32x4*)(WSP(float, ST_OASS) + (size_t)row * 16); const f32x4* pb = (const f32x4*)(WSP(float, ST_OBSS) + (size_t)row * 16);
                float sa = 0.f, sb = 0.f;
#pragma unroll
                for (int j = 0; j < 4; ++j) { const f32x4 a = pa[j], b = pb[j]; sa += (a[0] + a[1]) + (a[2] + a[3]); sb += (b[0] + b[1]) + (b[2] + b[3]); }
                ra[F.tid] = rsqrtf(sa * (1.f / WA) + EPS); rb[F.tid] = rsqrtf(sb * (1.f / WB) + EPS); }
            __syncthreads();
            OneUnit O{u};
            pg8::gemm_phase<EpiOut, OneUnit, false, true>(ring, pg8::Gemm{D, D, 16}, O, E);
        }
    }
    if constexpr (K == 7) { router_phase(args, F, CNT);
    }
    if constexpr (K == 8) {
        moe_tiles(F, CNT);
        const LAS int* tb = (const LAS int*)(F.lds + AUX_TB);
        { MoeOrder S{(const char*)DOP(bf16_t, DO_HB), (size_t)0, (const char*)WSP(bf16_t, WS_WGU), (size_t)512 * D * 2, (size_t)256 * D * 2, tb, WSP(int, ST_TOK), 2, F.G, c};
          EpiGU E{WSP(float, ST_TR), DOP(bf16_t, DO_HH)};
          pg8::gemm_phase<EpiGU, MoeOrder, true, false, true>(ring, pg8::Gemm{D, D, 16}, S, E); }
        { const int nunits = __builtin_amdgcn_readfirstlane(tb[NE]) * 2; int nb2 = nunits - F.G; nb2 = nb2 < 0 ? 0 : nb2;
          int rank = c, nshare = F.G; if (nb2 < F.G) { rank = c - nb2; nshare = F.G - nb2; }
          if (rank >= 0) { pg8::DenseOrder S; S.init(WSP(bf16_t, WS_PB), PLE, WSP(bf16_t, WS_WPP), PLE, M, D, nshare, rank);
              EpiBf E{WSP(bf16_t, WS_PP), D};
              pg8::gemm_phase<EpiBf, pg8::DenseOrder, true, false>(ring, pg8::Gemm{PLE, PLE, 4}, S, E); } }
    }
    if constexpr (K == 9) {
        moe_tiles(F, CNT);
        MoeOrder S{(const char*)DOP(bf16_t, DO_HH), (size_t)256 * FE * 2, (const char*)WSP(bf16_t, WS_WD), (size_t)D * FE * 2, (size_t)256 * FE * 2, (const LAS int*)(F.lds + AUX_TB), WSP(int, ST_TOK), 4, F.G, c};
        EpiDown E{WSP(float, ST_TW), WSP(bf16_t, WS_XS)};
        pg8::gemm_phase<EpiDown, MoeOrder, true, false>(ring, pg8::Gemm{FE, FE, 4}, S, E);
    }
    if constexpr (K == 10) {
        moe_tiles(F, CNT);
        const LAS int* tb = (const LAS int*)(F.lds + AUX_TB);
        const bf16_t* HB = DOP(bf16_t, DO_HB); const bf16_t* YE = WSP(bf16_t, WS_XS); bf16_t* H2B = WSP(bf16_t, WS_A0);
        const int* RE = WSP(int, ST_RE); const int* RP = WSP(int, ST_SLOT); float* R3 = WSP(float, ST_R3);
        const int gw = F.bid * NWAVES + F.wave, NGW = F.G * NWAVES;
        for (int m = gw; m < M; m += NGW) {
            const int e1 = RE[m * 2], e2 = RE[m * 2 + 1]; const int s1 = tb[e1] * 256 + RP[m * 2], s2 = tb[e2] * 256 + RP[m * 2 + 1];
            const u32x4* ph = (const u32x4*)(HB + (size_t)m * D); const u32x4* p1 = (const u32x4*)(YE + (size_t)s1 * D); const u32x4* p2 = (const u32x4*)(YE + (size_t)s2 * D);
            float ss = 0.f;
#pragma unroll
            for (int j = 0; j < 2; ++j) {
                const u32x4 a = ph[F.lane + 64 * j], b = p1[F.lane + 64 * j], cc = p2[F.lane + 64 * j];
                const unsigned aw[4] = {a.x, a.y, a.z, a.w}, bw[4] = {b.x, b.y, b.z, b.w}, cw[4] = {cc.x, cc.y, cc.z, cc.w}; unsigned ow[4];
#pragma unroll
                for (int q = 0; q < 4; ++q) { const float lo = lo16(aw[q]) + lo16(bw[q]) + lo16(cw[q]), hi_ = hi16(aw[q]) + hi16(bw[q]) + hi16(cw[q]); ss += lo * lo + hi_ * hi_; ow[q] = pk2(lo, hi_); }
                ((u32x4*)(H2B + (size_t)m * D))[F.lane + 64 * j] = (u32x4){ow[0], ow[1], ow[2], ow[3]};
            }
            ss = wave_sum(ss);
            if (F.lane == 0) R3[m] = rsqrtf(ss * (1.f / D) + EPS);
        }
    }
    if constexpr (K == 11) {
        pg8::DenseOrder S; S.init(WSP(bf16_t, WS_A0), D, WSP(bf16_t, WS_WPG), D, M, D, F.G, c);
        EpiPle E{WSP(bf16_t, WS_A0), WSP(bf16_t, WS_PP), WSP(float, ST_R3), args.out, WSP(float, ST_FSS)};
        pg8::gemm_phase<EpiPle, pg8::DenseOrder, true, false>(ring, pg8::Gemm{D, D, 16}, S, E);
    }
    if constexpr (K == 12) {
        const float* FSS = WSP(float, ST_FSS); const float* gf = args.in[31]; float* out = args.out;
        const int gw = F.bid * NWAVES + F.wave, NGW = F.G * NWAVES;
        f32x4 gv[4];
#pragma unroll
        for (int j = 0; j < 4; ++j) gv[j] = ((const f32x4*)gf)[F.lane + 64 * j];
        for (int m = gw; m < M; m += NGW) {
            const float sv = (F.lane < 16) ? FSS[(size_t)m * 16 + F.lane] : 0.f; const float r = rsqrtf(wave_sum(sv) * (1.f / D) + EPS);
            f32x4* o = (f32x4*)(out + (size_t)m * D) + F.lane;
#pragma unroll
            for (int j = 0; j < 4; ++j) { f32x4 v = o[64 * j]; v = v * r * gv[j]; o[64 * j] = v; }
        }
    }
}

__global__ void __launch_bounds__(NTHR, 2) mk_fwd(Args args) {
    extern __shared__ __attribute__((aligned(16))) unsigned char lds_raw[];
    Frame F;
    F.lds = (LAS unsigned char*)lds_raw; F.tid = threadIdx.x; F.lane = F.tid & 63; F.wave = __builtin_amdgcn_readfirstlane(F.tid >> 6);
    F.G = gridDim.x; F.bid = blockIdx.x;
    F.ws = args.ws; F.dout = (unsigned char*)args.out;
    unsigned* ctl = (unsigned*)(F.ws + WS_CTL);
    for (int u = F.tid; u < (LDS_BYTES - AUX_OFF) / 4; u += NTHR) ((LAS unsigned*)(F.lds + AUX_OFF))[u] = 0u;
    __syncthreads();
    XcdBarrier bar; bar.bar = ctl + CW_BAR; bar.x = 0; bar.st = nullptr;
#if !MK_PER_PHASE
    bar = xcd_barrier_post(ctl + CW_BAR, (volatile LAS unsigned*)(F.lds + AUX_MISC) + 8);
#endif
    const int lo = args.ph_lo, hi = args.ph_hi;
#ifndef PHMASK
#define PHMASK 0xFFFF
#endif
#define IN(k) ((((PHMASK) >> (k)) & 1) && lo <= (k) && (k) < hi)
#if MK_PER_PHASE
#define SEAM(k) do { } while (0)
#else
#define SEAM(k) do { if (IN(k) && IN((k) + 1)) xcd_barrier(bar); } while (0)
#endif
    typedef const Args __attribute__((address_space(4))) KArgs;
    KArgs* const kargs_ = (KArgs*)__builtin_amdgcn_kernarg_segment_ptr();
#define RUNP(k) do { Frame Fp_ = F; KArgs* ap_ = kargs_; asm volatile("" : "+s"(Fp_.ws), "+s"(Fp_.dout), "+s"(ap_)); phase_body<k>(*ap_, Fp_); } while (0)
#define PH(k) if (IN(k)) { RUNP(k); if (PHREP == (k)) { xcd_barrier(bar); RUNP(k); } } SEAM(k);
    PH(0) PH(1) PH(2) PH(3) PH(4) PH(5) PH(6) PH(7) PH(8) PH(9) PH(10) PH(11) PH(12)
#undef IN
#undef SEAM
}

extern "C" void kernel_launch(void* const* d_in, const int* in_sizes, int n_in, void* d_out, int out_size, void* d_ws, size_t ws_size, hipStream_t stream) {
    static int grid = 0;
    if (grid == 0) {
        if (n_in != 32 || in_sizes[0] != M * D || out_size != M * D || ws_size < WS_END) { fprintf(stderr, "kernel_launch: unexpected shapes (n_in %d, in0 %d, out %d, ws %zu, need %zu)\n", n_in, n_in > 0 ? in_sizes[0] : -1, out_size, ws_size, (size_t)WS_END); grid = -1; return; }
        int dev = 0, cus = 0, per_cu = 0;
        if (hipGetDevice(&dev) != hipSuccess || hipDeviceGetAttribute(&cus, hipDeviceAttributeMultiprocessorCount, dev) != hipSuccess) { grid = -1; return; }
        if (hipFuncSetAttribute((const void*)mk_fwd, hipFuncAttributeMaxDynamicSharedMemorySize, LDS_BYTES) != hipSuccess) { fprintf(stderr, "kernel_launch: hipFuncSetAttribute failed\n"); grid = -1; return; }
        if (hipOccupancyMaxActiveBlocksPerMultiprocessor(&per_cu, (const void*)mk_fwd, NTHR, LDS_BYTES) != hipSuccess || per_cu < 1) { fprintf(stderr, "kernel_launch: occupancy query says %d\n", per_cu); (void)hipGetLastError(); per_cu = 1; }
        grid = cus;
    }
    if (grid < 0) return;
    (void)hipMemsetAsync((char*)d_ws + WS_CTL, 0, CTL_ZERO, stream);
    Args a{};
    for (int i = 0; i < 32; ++i) a.in[i] = (const float*)d_in[i];
    a.out = (float*)d_out; a.ws = (unsigned char*)d_ws;
#if MK_PER_PHASE
    for (int ph = 0; ph <= NPHASE; ++ph) { a.ph_lo = ph; a.ph_hi = ph + 1; hipLaunchKernelGGL(mk_fwd, dim3(grid), dim3(NTHR), LDS_BYTES, stream, a); }
#else
    a.ph_lo = 0; a.ph_hi = NPHASE + 1;
    hipLaunchKernelGGL(mk_fwd, dim3(grid), dim3(NTHR), LDS_BYTES, stream, a);
#endif
}
```
